# Optimizing an MI355X kernel written in HIP

```python
import jax, jax.numpy as jnp
from jax import lax
import numpy as np

D_MODEL = 2048
BATCH = 2
SEQ = 8192
DEPTH = 4
DEC_BATCH = 2
DEC_SEQ = 16384
PAST_LEN = 128

MIX_DIM = D_MODEL
DN_HEADS = 8
DN_HEAD_DIM = 128
DN_DIM = DN_HEADS * DN_HEAD_DIM
SC_GROUPS = 8
SC_DIM = MIX_DIM - DN_DIM
SC_GROUP_DIM = SC_DIM // SC_GROUPS
CONV_WIDTH = 3
CHUNK = 64
D_FF = 5632
N_GATE_COLS = 4 * DN_HEADS
IN_COLS = 3 * DN_DIM + DN_DIM + N_GATE_COLS + 3 * SC_DIM
NORM_EPS = 1e-6
L2_EPS = 1e-6

kernel_name = 'hybrid_deltanet_shortconv_encoder'


def rms_norm(x, w):
    xf = x.astype(jnp.float32)
    y = xf * lax.rsqrt(jnp.mean(xf * xf, axis=-1, keepdims=True) + NORM_EPS)
    return (y * w.astype(jnp.float32)).astype(x.dtype)


def l2_norm(x):
    return x * lax.rsqrt(jnp.sum(x * x, axis=-1, keepdims=True) + L2_EPS)


def dwconv_centred(x, w):
    K = w.shape[0]
    p = K // 2
    T = x.shape[1]
    xp = jnp.pad(x, ((0, 0), (p, p), (0, 0)))
    return sum(xp[:, i:i + T] * w[i] for i in range(K))


def gated_delta_chunked(q, k, v, g, beta):
    N, T, H, Dk = q.shape
    Dv = v.shape[-1]
    NC = T // CHUNK

    def to_chunks(t):
        return t.reshape(N, NC, CHUNK, H, -1).transpose(1, 0, 3, 2, 4)

    q = to_chunks(q) * (Dk ** -0.5)
    k = to_chunks(k)
    v = to_chunks(v)
    g = g.reshape(N, NC, CHUNK, H).transpose(1, 0, 3, 2)
    beta = beta.reshape(N, NC, CHUNK, H).transpose(1, 0, 3, 2)
    g = jnp.cumsum(g, axis=-1)

    tri = jnp.tril(jnp.ones((CHUNK, CHUNK), dtype=bool))
    strict = jnp.tril(jnp.ones((CHUNK, CHUNK), dtype=bool), -1)
    eye = jnp.eye(CHUNK, dtype=q.dtype)
    diff = g[..., :, None] - g[..., None, :]
    decay = jnp.where(tri, jnp.exp(jnp.where(tri, diff, 0.0)), 0.0)

    kb = k * beta[..., None]
    vb = v * beta[..., None]
    a_kk = jnp.where(strict, jnp.einsum('znhcd,znhed->znhce', kb, k) * decay, 0.0)
    lower = a_kk + eye
    u = lax.linalg.triangular_solve(lower, vb, left_side=True, lower=True, unit_diagonal=True)
    w = lax.linalg.triangular_solve(lower, kb * jnp.exp(g)[..., None], left_side=True, lower=True, unit_diagonal=True)

    a_qk = jnp.einsum('znhcd,znhed->znhce', q, k) * decay
    qg = q * jnp.exp(g)[..., None]
    kdec = k * jnp.exp(g[..., -1:] - g)[..., None]
    glast = jnp.exp(g[..., -1])

    def step(S, xs):
        qg_i, kdec_i, u_i, w_i, a_i, gl_i = xs
        v_new = u_i - jnp.einsum('nhcd,nhde->nhce', w_i, S)
        o_i = jnp.einsum('nhcd,nhde->nhce', qg_i, S) + jnp.einsum('nhce,nhed->nhcd', a_i, v_new)
        S = S * gl_i[..., None, None] + jnp.einsum('nhcd,nhce->nhde', kdec_i, v_new)
        return S, o_i

    S0 = jnp.zeros((N, H, Dk, Dv), dtype=q.dtype)
    _, o = lax.scan(step, S0, (qg, kdec, u, w, a_qk, glast))
    return o.transpose(1, 0, 3, 2, 4).reshape(N, T, H, Dv)


def token_mixer(h, w_in, conv_qkv, a_log, dt_bias, dn_norm, conv_sc, sc_norm, w_out):
    B, T, _ = h.shape
    p = h @ w_in
    qkv, z, gl, sc = jnp.split(p, [3 * DN_DIM, 4 * DN_DIM, 4 * DN_DIM + N_GATE_COLS], axis=-1)

    qkv = jax.nn.silu(dwconv_centred(qkv, conv_qkv)).astype(jnp.float32)
    q, k, v = jnp.split(qkv, 3, axis=-1)
    q = l2_norm(q.reshape(B, T, DN_HEADS, DN_HEAD_DIM))
    k = l2_norm(k.reshape(B, T, DN_HEADS, DN_HEAD_DIM))
    v = v.reshape(B, T, DN_HEADS, DN_HEAD_DIM)
    gl = gl.astype(jnp.float32).reshape(B, T, 4, DN_HEADS)
    a_gate = gl[:, :, 0:2]
    b_gate = gl[:, :, 2:4]
    g = -jnp.exp(a_log.astype(jnp.float32)) * jax.nn.softplus(a_gate + dt_bias.astype(jnp.float32))
    beta = jax.nn.sigmoid(b_gate)
    flip = lambda t: jnp.flip(t, axis=1)
    q2 = jnp.concatenate([q, flip(q)], axis=0)
    k2 = jnp.concatenate([k, flip(k)], axis=0)
    v2 = jnp.concatenate([v, flip(v)], axis=0)
    g2 = jnp.concatenate([g[:, :, 0], flip(g[:, :, 1])], axis=0)
    beta2 = jnp.concatenate([beta[:, :, 0], flip(beta[:, :, 1])], axis=0)
    o2 = gated_delta_chunked(q2, k2, v2, g2, beta2)
    o = o2[:B] + flip(o2[B:])
    o = rms_norm(o, dn_norm) * jax.nn.silu(z.astype(jnp.float32).reshape(B, T, DN_HEADS, DN_HEAD_DIM))
    o_dn = o.reshape(B, T, DN_DIM).astype(h.dtype)

    b_g, c_g, x_sc = jnp.split(sc, 3, axis=-1)
    y = b_g * dwconv_centred(c_g * x_sc, conv_sc)
    y = rms_norm(y.reshape(B, T, SC_GROUPS, SC_GROUP_DIM), jnp.ones((SC_GROUP_DIM,), dtype=y.dtype))
    y_sc = y.reshape(B, T, SC_DIM) * sc_norm

    return jnp.concatenate([o_dn, y_sc], axis=-1) @ w_out


def conv_glu_ffn(h, w_up, conv_ffn, w_down):
    a, b = jnp.split(h @ w_up, 2, axis=-1)
    a = dwconv_centred(a, conv_ffn)
    return (jax.nn.silu(a) * b) @ w_down


def encoder_layer(x, norm_mix_pre, w_in, conv_qkv, a_log, dt_bias, dn_norm, conv_sc, sc_norm, w_out,
                  norm_mix_post, norm_ffn_pre, w_up, conv_ffn, w_down, norm_ffn_post):
    h = rms_norm(x, norm_mix_pre)
    x = x + rms_norm(token_mixer(h, w_in, conv_qkv, a_log, dt_bias, dn_norm, conv_sc, sc_norm, w_out), norm_mix_post)
    h = rms_norm(x, norm_ffn_pre)
    x = x + rms_norm(conv_glu_ffn(h, w_up, conv_ffn, w_down), norm_ffn_post)
    return x


def setup_inputs(seed: int = 0) -> dict:
    key = jax.random.key(seed)
    ks = jax.random.split(key, 20)
    f32 = jnp.float32
    nrm = lambda k, shape, s: jax.random.normal(k, shape, f32) * s
    gain = lambda k, shape: 1.0 + 0.05 * jax.random.normal(k, shape, f32)
    L = DEPTH
    dt = jnp.exp(jax.random.uniform(ks[5], (L, 2, DN_HEADS), f32, np.log(1e-3), np.log(1e-1)))
    return {
        'x_prompt': jax.random.normal(ks[0], (BATCH, SEQ, D_MODEL), f32),
        'x_sample': jax.random.normal(ks[1], (DEC_BATCH, DEC_SEQ, D_MODEL), f32),
        'norm_mix_pre': gain(ks[2], (L, D_MODEL)),
        'w_in': nrm(ks[3], (L, D_MODEL, IN_COLS), D_MODEL ** -0.5),
        'conv_qkv': nrm(ks[4], (L, CONV_WIDTH, 3 * DN_DIM), CONV_WIDTH ** -0.5),
        'a_log': jnp.log(jax.random.uniform(ks[6], (L, 2, DN_HEADS), f32, 1.0, 16.0)),
        'dt_bias': dt + jnp.log(-jnp.expm1(-dt)),
        'dn_norm': gain(ks[7], (L, DN_HEAD_DIM)),
        'conv_sc': nrm(ks[8], (L, CONV_WIDTH, SC_DIM), CONV_WIDTH ** -0.5),
        'sc_norm': gain(ks[9], (L, SC_DIM)),
        'w_out': nrm(ks[10], (L, MIX_DIM, D_MODEL), MIX_DIM ** -0.5),
        'norm_mix_post': gain(ks[11], (L, D_MODEL)),
        'norm_ffn_pre': gain(ks[12], (L, D_MODEL)),
        'w_up': nrm(ks[13], (L, D_MODEL, 2 * D_FF), D_MODEL ** -0.5),
        'conv_ffn': nrm(ks[14], (L, CONV_WIDTH, D_FF), CONV_WIDTH ** -0.5),
        'w_down': nrm(ks[15], (L, D_FF, D_MODEL), D_FF ** -0.5),
        'norm_ffn_post': gain(ks[16], (L, D_MODEL)),
    }


def reference(x_prompt, x_sample, norm_mix_pre, w_in, conv_qkv, a_log, dt_bias, dn_norm, conv_sc, sc_norm,
              w_out, norm_mix_post, norm_ffn_pre, w_up, conv_ffn, w_down, norm_ffn_post):
    y_prompt = x_prompt
    y_sample = x_sample
    for l in range(DEPTH):
        layer_params = (norm_mix_pre[l], w_in[l], conv_qkv[l], a_log[l], dt_bias[l], dn_norm[l], conv_sc[l],
                        sc_norm[l], w_out[l], norm_mix_post[l], norm_ffn_pre[l], w_up[l], conv_ffn[l], w_down[l],
                        norm_ffn_post[l])
        y_prompt = encoder_layer(y_prompt, *layer_params)
        y_sample = encoder_layer(y_sample, *layer_params)
    return (y_prompt, y_sample)
```

```cpp
#include <hip/hip_runtime.h>
#include <cstdio>
#include <cstdint>
namespace pg8 {
#define PG8_LAS __attribute__((address_space(3)))
typedef unsigned short bf16_t;
typedef short bf16x8 __attribute__((ext_vector_type(8)));
typedef float f32x4 __attribute__((ext_vector_type(4)));
typedef unsigned u32x4 __attribute__((ext_vector_type(4)));
constexpr int BM = 256, BK = 64, HALF = 128, HTB = HALF * BK * 2  , STAGE_BYTES = 8 * HTB, NXCD = 8, WGM = 2;

__host__ __device__ __forceinline__ int lds_byte(int r, int c) { const int st = (r >> 4) * 2 + (c >> 5), rr = r & 15, cc = c & 31, ob = rr * 64 + cc * 2; return st * 1024 + (ob ^ (((ob >> 9) & 1) << 5)); }
__host__ __device__ __forceinline__ void stage_rc(int b, int& R, int& C) { const int st = b / 1024, sb = b % 1024, swz = sb ^ (((sb >> 9) & 1) << 5); R = (st >> 1) * 16 + swz / 64; C = (st & 1) * 32 + (swz % 64) / 2; }
__host__ __device__ __forceinline__ int perm32(int rho) { const int n = rho >> 4, i = rho & 15; return 8 * (i >> 2) + 4 * n + (i & 3); }

struct Unit { int pm, pn; };
struct Gemm { const bf16_t* A; const bf16_t* Bt; int M, N, K; };

struct StaticOrder {
    int nM, nN, nwg, G, c;
    __host__ __device__ void init(int M, int N, int G_, int c_) { nM = M / BM; nN = N / BM; nwg = nM * nN; G = G_; c = c_; }
    __host__ __device__ bool next(int i, Unit& u) const {
        const long L = (long)i * G + c; if (L >= nwg) return false;
        int wgid = (int)L; { const int q = nwg / NXCD, r = nwg % NXCD, xcd = wgid % NXCD, off = wgid / NXCD; wgid = (xcd < r ? xcd * (q + 1) : r * (q + 1) + (xcd - r) * q) + off; }
        const int nig = WGM * nN, gid = wgid / nig, fm = gid * WGM, gsz = (nM - fm) < WGM ? (nM - fm) : WGM;
        u.pm = fm + ((wgid % nig) % gsz); u.pn = (wgid % nig) / gsz; return true;
    }
    __device__ __forceinline__ void a_ready(const Unit&) const {}
    __device__ __forceinline__ void done(const Unit&) const {}
};
__device__ __forceinline__ unsigned cvt_pk_bf16(float lo, float hi) { unsigned r; asm volatile("v_cvt_pk_bf16_f32 %0, %1, %2" : "=v"(r) : "v"(lo), "v"(hi)); return r; }
typedef float f32x2 __attribute__((ext_vector_type(2)));
struct RangeOrder : StaticOrder {
    int L0, L1, Gs, cs;
    __device__ bool next(int i, Unit& u) const {
        const long L = (long)L0 + (long)i * Gs + cs; if (cs < 0 || L >= L1) return false;
        int wgid = (int)L; { const int q = nwg / NXCD, r = nwg % NXCD, xcd = wgid % NXCD, off = wgid / NXCD; wgid = (xcd < r ? xcd * (q + 1) : r * (q + 1) + (xcd - r) * q) + off; }
        const int nig = WGM * nN, gid = wgid / nig, fm = gid * WGM, gsz = (nM - fm) < WGM ? (nM - fm) : WGM;
        u.pm = fm + ((wgid % nig) % gsz); u.pn = (wgid % nig) / gsz; return true;
    }
};
struct EpiBf16R {
    static constexpr bool PERM = true, AFTER_DRAIN = false, BH32 = true;
    bf16_t* O0; int ld0; int npn0; bf16_t* O1; int ld1;
    __device__ __forceinline__ void operator()(const f32x4 (&acc)[2][2][4][2], const Unit& u, int wr, int wc, int fr, int fq) const {
        const int lane = 16 * fq + fr, sr = lane >> 3, sp = lane & 7;
        const int src = (16 * (sp & 3) + sr + 8 * (sp >> 2)) << 2;
        const int row0 = u.pm * BM + wr * 64 + sr;
        bf16_t* base; int ldc, colt;
        if (u.pn < npn0) { base = O0; ldc = ld0; colt = u.pn * BM; } else { base = O1; ldc = ld1; colt = (u.pn - npn0) * BM; }
        const int col0 = colt + wc * 64 + 8 * sp;
#pragma unroll
        for (int ai = 0; ai < 2; ++ai)
#pragma unroll
            for (int m = 0; m < 4; ++m) { bf16_t* rowp = base + (size_t)(row0 + ai * HALF + m * 16) * ldc + col0;
                unsigned w0[4], w1[4];
#pragma unroll
                for (int bj = 0; bj < 2; ++bj) { const f32x4 v0 = acc[ai][bj][m][0], v1 = acc[ai][bj][m][1]; unsigned* w = bj ? w1 : w0;
                    w[0] = cvt_pk_bf16(v0[0], v0[1]); w[1] = cvt_pk_bf16(v0[2], v0[3]); w[2] = cvt_pk_bf16(v1[0], v1[1]); w[3] = cvt_pk_bf16(v1[2], v1[3]); }
                u32x4 a, b;
#pragma unroll
                for (int q = 0; q < 4; ++q) {
                    const int ea = __builtin_amdgcn_update_dpp((int)w0[q], (int)w1[q], 0x118, 0xf, 0xf, false);
                    const int eb = __builtin_amdgcn_update_dpp((int)w0[q], (int)w1[q], 0x108, 0xf, 0xf, false);
                    a[q] = (unsigned)__builtin_amdgcn_ds_bpermute(src, ea);
                    b[q] = (unsigned)__builtin_amdgcn_ds_bpermute(src ^ (8 << 2), eb); }
                *(u32x4*)(rowp) = a; *(u32x4*)(rowp + (size_t)8 * ldc) = b; }
    }
};
struct EpiGlu {
    static constexpr bool PERM = true, AFTER_DRAIN = false, BH32 = false;
    bf16_t* HM; const float* cw; float* SA; float* SB; PG8_LAS float* XL; int dff;
    __device__ __forceinline__ void operator()(const f32x4 (&acc)[2][2][4][2], const Unit& u, int wr, int wc, int fr, int fq) const {
        const int chl = 32 * wc + 8 * fq, ch0 = 128 * u.pn + chl;
        f32x4 w0[2], w1[2], w2[2];
#pragma unroll
        for (int n = 0; n < 2; ++n) { w0[n] = *(const f32x4*)(cw + ch0 + 4 * n); w1[n] = *(const f32x4*)(cw + dff + ch0 + 4 * n); w2[n] = *(const f32x4*)(cw + 2 * dff + ch0 + 4 * n); }
#pragma unroll
        for (int ai = 0; ai < 2; ++ai) { const int bi = 2 * ai + wr;
            if (fr == 0) {
#pragma unroll
                for (int n = 0; n < 2; ++n) *(PG8_LAS f32x4*)(XL + bi * 128 + chl + 4 * n) = acc[ai][0][0][n]; }
            if (fr == 15) {
#pragma unroll
                for (int n = 0; n < 2; ++n) *(PG8_LAS f32x4*)(XL + 512 + bi * 128 + chl + 4 * n) = acc[ai][0][3][n]; }
        }
        if (wr == 0 && fr < 2) {
#pragma unroll
            for (int n = 0; n < 2; ++n) { *(f32x4*)(SA + ((size_t)u.pm * 4 + fr) * dff + ch0 + 4 * n) = acc[0][0][0][n]; if (fr == 0) *(f32x4*)(SB + ((size_t)u.pm * 2) * dff + ch0 + 4 * n) = acc[0][1][0][n]; } }
        if (wr == 1 && fr >= 14) {
#pragma unroll
            for (int n = 0; n < 2; ++n) { *(f32x4*)(SA + ((size_t)u.pm * 4 + fr - 12) * dff + ch0 + 4 * n) = acc[1][0][3][n]; if (fr == 15) *(f32x4*)(SB + ((size_t)u.pm * 2 + 1) * dff + ch0 + 4 * n) = acc[1][1][3][n]; } }
        asm volatile("s_waitcnt lgkmcnt(0)\n\ts_barrier" ::: "memory");
        f32x4 w0m[2], w2m[2];
#pragma unroll
        for (int n = 0; n < 2; ++n)
#pragma unroll
            for (int j = 0; j < 4; ++j) { w0m[n][j] = fr == 0 ? w0[n][j] : 0.f; w2m[n][j] = fr == 15 ? w2[n][j] : 0.f; }
#pragma unroll
        for (int ai = 0; ai < 2; ++ai) { const int bi = 2 * ai + wr;
            unsigned ow[4][4];
#pragma unroll
            for (int n = 0; n < 2; ++n) {
                const f32x4 pblk = bi > 0 ? *(const PG8_LAS f32x4*)(XL + 512 + (bi - 1) * 128 + chl + 4 * n) : (f32x4){0.f, 0.f, 0.f, 0.f};
                const f32x4 nblk = bi < 3 ? *(const PG8_LAS f32x4*)(XL + (bi + 1) * 128 + chl + 4 * n) : (f32x4){0.f, 0.f, 0.f, 0.f};
#pragma unroll
                for (int m = 0; m < 4; ++m) { float o[4]; f32x2 sv[2];
#pragma unroll
                    for (int jp = 0; jp < 4; jp += 2) {
                        const float c0 = acc[ai][0][m][n][jp], c1 = acc[ai][0][m][n][jp + 1];
                        const float p0 = m > 0 ? acc[ai][0][m > 0 ? m - 1 : 0][n][jp] : pblk[jp], p1 = m > 0 ? acc[ai][0][m > 0 ? m - 1 : 0][n][jp + 1] : pblk[jp + 1];
                        const float n0 = m < 3 ? acc[ai][0][m < 3 ? m + 1 : 3][n][jp] : nblk[jp], n1 = m < 3 ? acc[ai][0][m < 3 ? m + 1 : 3][n][jp + 1] : nblk[jp + 1];
                        float s0, s1;
                        asm("v_mul_f32 %0, %8, %2\n\tv_mul_f32 %1, %9, %3\n\t"
                            "v_fmac_f32_dpp %0, %2, %10 row_shr:1 row_mask:0xf bank_mask:0xf bound_ctrl:1\n\t"
                            "v_fmac_f32_dpp %1, %3, %11 row_shr:1 row_mask:0xf bank_mask:0xf bound_ctrl:1\n\t"
                            "v_fmac_f32_dpp %0, %2, %12 row_shl:1 row_mask:0xf bank_mask:0xf bound_ctrl:1\n\t"
                            "v_fmac_f32_dpp %1, %3, %13 row_shl:1 row_mask:0xf bank_mask:0xf bound_ctrl:1\n\t"
                            "v_fmac_f32_dpp %0, %4, %14 row_ror:1 row_mask:0xf bank_mask:0xf bound_ctrl:1\n\t"
                            "v_fmac_f32_dpp %1, %5, %15 row_ror:1 row_mask:0xf bank_mask:0xf bound_ctrl:1\n\t"
                            "v_fmac_f32_dpp %0, %6, %16 row_ror:15 row_mask:0xf bank_mask:0xf bound_ctrl:1\n\t"
                            "v_fmac_f32_dpp %1, %7, %17 row_ror:15 row_mask:0xf bank_mask:0xf bound_ctrl:1"
                            : "=&v"(s0), "=&v"(s1)
                            : "v"(c0), "v"(c1), "v"(p0), "v"(p1), "v"(n0), "v"(n1), "v"(w1[n][jp]), "v"(w1[n][jp + 1]), "v"(w0[n][jp]), "v"(w0[n][jp + 1]),
                              "v"(w2[n][jp]), "v"(w2[n][jp + 1]), "v"(w0m[n][jp]), "v"(w0m[n][jp + 1]), "v"(w2m[n][jp]), "v"(w2m[n][jp + 1]));
                        sv[jp >> 1] = (f32x2){s0, s1}; }
                    const f32x2 ta = sv[0] * -1.4426950408889634f, tb = sv[1] * -1.4426950408889634f;
                    const f32x2 da = (f32x2){__builtin_amdgcn_exp2f(ta.x), __builtin_amdgcn_exp2f(ta.y)} + 1.f, db = (f32x2){__builtin_amdgcn_exp2f(tb.x), __builtin_amdgcn_exp2f(tb.y)} + 1.f;
                    const f32x2 va = {acc[ai][1][m][n][0], acc[ai][1][m][n][1]}, vb = {acc[ai][1][m][n][2], acc[ai][1][m][n][3]};
                    const f32x2 pa = sv[0] * va, pb2 = sv[1] * vb;
                    const f32x2 oa = pa * (f32x2){__builtin_amdgcn_rcpf(da.x), __builtin_amdgcn_rcpf(da.y)}, ob = pb2 * (f32x2){__builtin_amdgcn_rcpf(db.x), __builtin_amdgcn_rcpf(db.y)};
                    o[0] = oa.x; o[1] = oa.y; o[2] = ob.x; o[3] = ob.y;
                    ow[m][2 * n] = cvt_pk_bf16(o[0], o[1]); ow[m][2 * n + 1] = cvt_pk_bf16(o[2], o[3]); }
            }
#pragma unroll
            for (int m = 0; m < 4; ++m) { u32x4 w; w.x = ow[m][0]; w.y = ow[m][1]; w.z = ow[m][2]; w.w = ow[m][3];
                *(u32x4*)(HM + (size_t)(u.pm * BM + 128 * ai + 64 * wr + 16 * m + fr) * dff + ch0) = w; }
        }
    }
};
template <class Epi, class Sched, bool ALIGN_EPI = false, bool SP2 = false>
__device__ __forceinline__ void gemm_phase(PG8_LAS unsigned char* lds, const Gemm g, const Sched& S, const Epi& E) {
    int tid_o = threadIdx.x; asm volatile("" : "+v"(tid_o)); const int tid = tid_o, wid = __builtin_amdgcn_readfirstlane(tid >> 6), lane = tid & 63, wr = wid >> 2, wc = wid & 3, fr = lane & 15, fq = lane >> 4;
    const int K = g.K, nt = K / BK;
    unsigned voffA[2], voffB[2];
#pragma unroll
    for (int i = 0; i < 2; ++i) { int R, C; stage_rc(tid * 16 + i * 8192, R, C); const int Rb = Epi::BH32 ? ((R >> 5) * 64 + perm32(R & 31)) : Epi::PERM ? ((R & ~31) + perm32(R & 31)) : R;
        voffA[i] = (unsigned)(R * K + C) * 2u; voffB[i] = (unsigned)(Rb * K + C) * 2u; }
    const size_t kstep = (size_t)(BK * 2);
    const size_t hstep = (size_t)HALF * K * 2;
    const size_t tstep = 2 * hstep;
    const size_t hstepB = Epi::BH32 ? (size_t)32 * K * 2 : hstep;
    const unsigned ldsw = (unsigned)wid * 1024u;
    const int aoff = lds_byte(wr * 64 + fr, fq * 8), boff = lds_byte(wc * 32 + fr, fq * 8);
#define PG8_SA(b, h) (((b) * 2 + (h)) * HTB)
#define PG8_SB(b, h) ((4 + (b) * 2 + (h)) * HTB)
#define PG8_STAGE(bufoff, gbase, voff) do { _Pragma("unroll") for (int _i = 0; _i < 2; ++_i) \
        __builtin_amdgcn_global_load_lds((const unsigned*)((const char*)(gbase) + (voff)[_i]), (PG8_LAS unsigned*)(lds + (bufoff) + ldsw + _i * 8192), 16, 0, 0); } while (0)
#define PG8_LDA(dst, b, h) do { _Pragma("unroll") for (int m = 0; m < 4; ++m) _Pragma("unroll") for (int k = 0; k < 2; ++k) dst[m][k] = *(const PG8_LAS bf16x8*)(lds + PG8_SA(b, h) + aoff + m * 2048 + k * 1024); } while (0)
#define PG8_LDB(dst, b, h) do { _Pragma("unroll") for (int n = 0; n < 2; ++n) _Pragma("unroll") for (int k = 0; k < 2; ++k) dst[n][k] = *(const PG8_LAS bf16x8*)(lds + PG8_SB(b, h) + boff + n * 2048 + k * 1024); } while (0)
#define PG8_MMA(ai, bj, At, Bt) do { __builtin_amdgcn_s_setprio(1); _Pragma("unroll") for (int m = 0; m < 4; ++m) _Pragma("unroll") for (int n = 0; n < 2; ++n) _Pragma("unroll") for (int k = 0; k < 2; ++k) \
        acc[ai][bj][m][n] = __builtin_amdgcn_mfma_f32_16x16x32_bf16(Bt[n][k], At[m][k], acc[ai][bj][m][n], 0, 0, 0); __builtin_amdgcn_s_setprio(0); } while (0)
#define PG8_WAIT_V(n) asm volatile("s_waitcnt vmcnt(" #n ")" ::: "memory")
#define PG8_WAIT_L(n) asm volatile("s_waitcnt lgkmcnt(" #n ")" ::: "memory")
#define PG8_BAR __builtin_amdgcn_s_barrier()
#define PG8_SCHED __builtin_amdgcn_sched_barrier(0)
    Unit cur, nxt; int ui = 0;
    if (!S.next(0, cur)) return;
    f32x4 acc[2][2][4][2];
#pragma unroll
    for (int a = 0; a < 2; ++a)
#pragma unroll
        for (int b = 0; b < 2; ++b)
#pragma unroll
            for (int m = 0; m < 4; ++m)
#pragma unroll
                for (int n = 0; n < 2; ++n) acc[a][b][m][n] = (f32x4){0.f, 0.f, 0.f, 0.f};
    bf16x8 At[4][2], B0[2][2], B1[2][2];
    const char* cA = (const char*)g.A + (size_t)cur.pm * tstep; const char* cB = (const char*)g.Bt + (size_t)cur.pn * tstep;
    S.a_ready(cur);
    if constexpr (SP2) {
        PG8_STAGE(PG8_SB(0, 0), cB, voffB); PG8_STAGE(PG8_SB(0, 1), cB + hstepB, voffB); PG8_STAGE(PG8_SA(0, 0), cA, voffA); PG8_STAGE(PG8_SA(0, 1), cA + hstep, voffA);
        if (wr == 1) PG8_BAR;
        PG8_WAIT_V(2); PG8_BAR;
        PG8_STAGE(PG8_SB(1, 0), cB + kstep, voffB); PG8_STAGE(PG8_SA(1, 0), cA + kstep, voffA); PG8_STAGE(PG8_SB(1, 1), cB + hstepB + kstep, voffB);
        PG8_WAIT_V(6); PG8_BAR;
    } else {
        PG8_STAGE(PG8_SB(0, 0), cB, voffB); PG8_STAGE(PG8_SA(0, 0), cA, voffA); PG8_STAGE(PG8_SB(0, 1), cB + hstepB, voffB); PG8_STAGE(PG8_SA(0, 1), cA + hstep, voffA);
        if (wr == 1) PG8_BAR;
        PG8_WAIT_V(4); PG8_BAR;
        PG8_STAGE(PG8_SB(1, 0), cB + kstep, voffB); PG8_STAGE(PG8_SA(1, 0), cA + kstep, voffA); PG8_STAGE(PG8_SB(1, 1), cB + hstepB + kstep, voffB);
        PG8_WAIT_V(6); PG8_BAR;
    }
    for (;;) {
        const bool has_next = S.next(ui + 1, nxt);
        const char* nA = has_next ? (const char*)g.A + (size_t)nxt.pm * tstep : cA; const char* nB = has_next ? (const char*)g.Bt + (size_t)nxt.pn * tstep : cB;
        for (int t = 0; t < nt; t += 2) {
            const bool last = (t == nt - 2);
            const char* a1 = cA + (size_t)(t + 1) * kstep;
            const char* a2 = last ? nA : cA + (size_t)(t + 2) * kstep; const char* b2 = last ? nB : cB + (size_t)(t + 2) * kstep;
            const char* a3 = a2 + kstep; const char* b3 = b2 + kstep;
            if (last && has_next) S.a_ready(nxt);
            if constexpr (SP2) {
            PG8_LDB(B0, 0, 0); PG8_LDB(B1, 0, 1); PG8_SCHED; PG8_LDA(At, 0, 0); PG8_STAGE(PG8_SA(1, 1), a1 + hstep, voffA);
            PG8_WAIT_V(8); PG8_WAIT_L(0); PG8_BAR; PG8_MMA(0, 0, At, B0); PG8_MMA(0, 1, At, B1); PG8_BAR; PG8_SCHED;
            PG8_LDA(At, 0, 1); PG8_STAGE(PG8_SB(0, 0), b2, voffB); PG8_STAGE(PG8_SB(0, 1), b2 + hstepB, voffB); PG8_STAGE(PG8_SA(0, 0), a2, voffA);
            PG8_WAIT_V(8); PG8_WAIT_L(0); PG8_BAR; PG8_MMA(1, 0, At, B0); PG8_MMA(1, 1, At, B1); PG8_BAR; PG8_SCHED;
            PG8_LDB(B0, 1, 0); PG8_LDB(B1, 1, 1); PG8_SCHED; PG8_LDA(At, 1, 0); PG8_STAGE(PG8_SA(0, 1), a2 + hstep, voffA);
            PG8_WAIT_V(8); PG8_WAIT_L(0); PG8_BAR; PG8_MMA(0, 0, At, B0); PG8_MMA(0, 1, At, B1); PG8_BAR; PG8_SCHED;
            PG8_LDA(At, 1, 1); PG8_STAGE(PG8_SB(1, 0), b3, voffB); PG8_STAGE(PG8_SB(1, 1), b3 + hstepB, voffB); PG8_STAGE(PG8_SA(1, 0), a3, voffA);
            PG8_WAIT_V(8); PG8_WAIT_L(0); PG8_BAR; PG8_MMA(1, 0, At, B0); PG8_MMA(1, 1, At, B1); PG8_BAR; PG8_SCHED;
            } else {
            PG8_LDB(B0, 0, 0); PG8_SCHED; PG8_LDA(At, 0, 0); PG8_STAGE(PG8_SA(1, 1), a1 + hstep, voffA);
            PG8_WAIT_L(8); PG8_BAR; PG8_WAIT_L(0); PG8_MMA(0, 0, At, B0); PG8_BAR; PG8_SCHED;
            PG8_LDB(B1, 0, 1); PG8_STAGE(PG8_SB(0, 0), b2, voffB);
            PG8_BAR; PG8_WAIT_L(0); PG8_MMA(0, 1, At, B1); PG8_BAR;
            PG8_LDA(At, 0, 1); PG8_STAGE(PG8_SA(0, 0), a2, voffA);
            PG8_BAR; PG8_WAIT_L(0); PG8_MMA(1, 0, At, B0); PG8_BAR; PG8_SCHED;
            PG8_STAGE(PG8_SB(0, 1), b2 + hstepB, voffB);
            PG8_WAIT_V(6); PG8_BAR; PG8_MMA(1, 1, At, B1); PG8_BAR;
            PG8_LDB(B0, 1, 0); PG8_SCHED; PG8_LDA(At, 1, 0); PG8_STAGE(PG8_SA(0, 1), a2 + hstep, voffA);
            PG8_WAIT_L(8); PG8_BAR; PG8_WAIT_L(0); PG8_MMA(0, 0, At, B0); PG8_BAR; PG8_SCHED;
            PG8_LDB(B1, 1, 1); PG8_STAGE(PG8_SB(1, 0), b3, voffB);
            PG8_BAR; PG8_WAIT_L(0); PG8_MMA(0, 1, At, B1); PG8_BAR;
            PG8_LDA(At, 1, 1); PG8_STAGE(PG8_SA(1, 0), a3, voffA);
            PG8_BAR; PG8_WAIT_L(0); PG8_MMA(1, 0, At, B0); PG8_BAR; PG8_SCHED;
            PG8_STAGE(PG8_SB(1, 1), b3 + hstepB, voffB);
            PG8_WAIT_V(6); PG8_BAR; PG8_MMA(1, 1, At, B1); PG8_BAR;
            }
        }
        if constexpr (ALIGN_EPI) { if (wr == 0) PG8_BAR; }
        if constexpr (!Epi::AFTER_DRAIN) { E(acc, cur, wr, wc, fr, fq); S.done(cur); }
        if (!has_next) break;
#pragma unroll
        for (int a = 0; a < 2; ++a)
#pragma unroll
            for (int b = 0; b < 2; ++b)
#pragma unroll
                for (int m = 0; m < 4; ++m)
#pragma unroll
                    for (int n = 0; n < 2; ++n) acc[a][b][m][n] = (f32x4){0.f, 0.f, 0.f, 0.f};
        cur = nxt; cA = nA; cB = nB; ++ui;
        if constexpr (ALIGN_EPI) { if (wr == 1) PG8_BAR; }
    }
    PG8_WAIT_V(0);
    if constexpr (!ALIGN_EPI) { if (wr == 0) PG8_BAR; }
    PG8_BAR;
    if constexpr (Epi::AFTER_DRAIN) { E.fused(acc, cur, wr, wc, fr, fq, lds, wid, lane); S.done(cur); }
#undef PG8_SA
#undef PG8_SB
#undef PG8_STAGE
#undef PG8_LDA
#undef PG8_LDB
#undef PG8_MMA
#undef PG8_WAIT_V
#undef PG8_WAIT_L
#undef PG8_BAR
#undef PG8_SCHED
}
}
#ifndef PG8_SP2
#define PG8_SP2 true
#endif
#ifndef PG8_ALIGN
#define PG8_ALIGN true
#endif

constexpr int NWAVES = 8;
constexpr int DM = 2048, DEPTH = 4, TP = 16384, TSM = 32768, TT = TP + TSM;
constexpr int NQKV = 3072, NDNR = 4128, NDN = 4352, NSC = 3072, NIN = NDN + NSC, INCOLS = 7200;
constexpr int DFF = 5632, NUP = 2 * DFF;
constexpr int NHEAD = 8, HD = 128, CH = 64;
constexpr int SECROWS = 16384, NSEC = 3;
constexpr float NORM_EPS = 1e-6f, L2_EPS = 1e-6f;

constexpr size_t MiB = 1u << 20;
constexpr size_t WS_CTL = 0, CTL_ZERO_BYTES = 1 * MiB;
constexpr size_t WS_WIN = 1 * MiB, WS_WOUT = 30 * MiB, WS_WUP = 38 * MiB, WS_WDN = 82 * MiB;
constexpr size_t OFF_H = 0, OFF_QN = 0, OFF_KN = 2048, OFF_MIX = 4096, OFF_PDN = 8192, OFF_M = 8192, OFF_HMID = 4096, OFF_PSC = 16896, OFF_W0 = 16896, OFF_W1 = 18944, OFF_UT0 = 20992, OFF_F = 16896;
constexpr size_t OFF_UT1 = 23040, OFF_SA = 23040, OFF_SB = 23392, OFF_AQ0 = 25088, OFF_AQ1 = 26112, OFF_GC0 = 27136, OFF_GC1 = 27232, ROW_BYTES = 27328;
constexpr size_t WS_ARENA_P = 105 * MiB, WS_ARENA_S = WS_ARENA_P + ROW_BYTES * TP, WS_END = WS_ARENA_S + ROW_BYTES * TSM;
static_assert(WS_WIN + (size_t)NIN * DM * 2 <= WS_WOUT && WS_WOUT + (size_t)DM * DM * 2 <= WS_WUP && WS_WUP + (size_t)NUP * DM * 2 <= WS_WDN && WS_WDN + (size_t)DM * DFF * 2 <= WS_ARENA_P, "weights map");
static_assert(WS_END <= 1408 * MiB && OFF_HMID + 11264 <= OFF_F && OFF_SB + 176 <= OFF_AQ0 && OFF_M + 4096 <= OFF_PSC, "arena map");
constexpr int CW_BAR = 4096;

constexpr int RING_OFF = 0, RING_BYTES = 147456;
constexpr int EXTRA_OFF = RING_BYTES, LDSCTL_OFF = RING_BYTES + 8192, MISC_OFF = LDSCTL_OFF + 320;
constexpr int LDS_BYTES = RING_BYTES + 8192 + 512;

#define GAS __attribute__((address_space(1)))
#define LAS __attribute__((address_space(3)))
typedef unsigned short bf16;
typedef unsigned v4u __attribute__((ext_vector_type(4)));
typedef unsigned v2u __attribute__((ext_vector_type(2)));
typedef float f32x4 __attribute__((ext_vector_type(4)));
typedef GAS unsigned gu32;
#define RLX_AGENT __ATOMIC_RELAXED, __HIP_MEMORY_SCOPE_AGENT
#define LDS_WAIT() asm volatile("s_waitcnt lgkmcnt(0)" ::: "memory")
#define VM_WAIT() asm volatile("s_waitcnt vmcnt(0)" ::: "memory")
#define LDS_BAR() asm volatile("s_waitcnt lgkmcnt(0)\n\ts_barrier" ::: "memory")
typedef __bf16 bf2_t __attribute__((ext_vector_type(2)));
typedef float f2_t __attribute__((ext_vector_type(2)));
__device__ __forceinline__ unsigned cvt2(float a, float b) { const f2_t v = {a, b}; return __builtin_bit_cast(unsigned, __builtin_convertvector(v, bf2_t)); }
__device__ __forceinline__ unsigned f2bf(float f) { unsigned u = __builtin_bit_cast(unsigned, f); return (u + 0x7fffu + ((u >> 16) & 1u)) >> 16; }
__device__ __forceinline__ unsigned pk2(float lo, float hi) { return cvt2(lo, hi); }
__device__ __forceinline__ float bflo(unsigned u) { return __builtin_bit_cast(float, u << 16); }
__device__ __forceinline__ float bfhi(unsigned u) { return __builtin_bit_cast(float, u & 0xffff0000u); }
__device__ __forceinline__ float bf1(bf16 b) { return __builtin_bit_cast(float, ((unsigned)b) << 16); }
__device__ __forceinline__ void unpack8(const v4u w, float (&f)[8]) { f[0] = bflo(w.x); f[1] = bfhi(w.x); f[2] = bflo(w.y); f[3] = bfhi(w.y); f[4] = bflo(w.z); f[5] = bfhi(w.z); f[6] = bflo(w.w); f[7] = bfhi(w.w); }
__device__ __forceinline__ float wave_sum(float v) {
#pragma unroll
    for (int o = 1; o < 64; o <<= 1) v += __shfl_xor(v, o);
    return v;
}
__device__ __forceinline__ float siluf(float x) { return x * __builtin_amdgcn_rcpf(1.f + __expf(-x)); }
__device__ __forceinline__ void seq_bounds(int r, int& start, int& len) {
    if (r < TP) { len = 8192; start = r & ~8191; } else { len = 16384; start = TP + ((r - TP) & ~16383); }
}
#define XB_TMO      128
#define XB_XCNT(j)  (256  + 64 * (j))
#define XB_XSUB(j)  (1280 + 64 * (j))
#define XB_XGEN(j)  (2304 + 64 * (j))
#define XB_TOP      3328
#define XB_TOPGEN   3392
#define XB_SUBW     3456
#define XCD_BAR_WORDS 3456
#define XB_SPIN_CAP (1u << 18)

__device__ __forceinline__ unsigned xb_ld(unsigned* p)              { return __hip_atomic_load(p, __ATOMIC_RELAXED, __HIP_MEMORY_SCOPE_AGENT); }
__device__ __forceinline__ unsigned xb_add(unsigned* p, unsigned v) { return __hip_atomic_fetch_add(p, v, __ATOMIC_RELAXED, __HIP_MEMORY_SCOPE_AGENT); }
__device__ __forceinline__ unsigned xb_xcc_id() { return (unsigned)__builtin_amdgcn_s_getreg((3 << 11) | 20) & 0xFu; }
#define XB_SPIN(cond, bar) do { unsigned _sp = 0; while (cond) { __builtin_amdgcn_s_sleep(1); \
    if ((++_sp & 255u) == 0u) { if (xb_ld(&(bar)[XB_TMO])) break; if (_sp > XB_SPIN_CAP) { atomicAdd(&(bar)[XB_TMO], 1u); break; } } } } while (0)

struct XcdBarrier {
    unsigned* bar; unsigned x;
    volatile LAS unsigned* st;
};

__device__ __forceinline__ XcdBarrier xcd_barrier_post(unsigned* bar, volatile LAS unsigned* st) {
    XcdBarrier b; b.bar = bar; b.x = xb_xcc_id(); b.st = st;
    if (threadIdx.x == 0) (void)xb_add(&bar[XB_XCNT(b.x)], 1u);
    return b;
}
__device__ __forceinline__ void xcd_barrier_complete(unsigned* bar, unsigned x, unsigned& nloc, unsigned& nx) {
    const unsigned G = gridDim.x * gridDim.y * gridDim.z;
    unsigned sum, cnt, mine, sp = 0u;
    for (;;) {
        sum = 0u; cnt = 0u; mine = 0u;
#pragma unroll
        for (unsigned j = 0; j < 16; ++j) { const unsigned c = xb_ld(&bar[XB_XCNT(j)]); sum += c; cnt += (c > 0u) ? 1u : 0u; mine = (j == x) ? c : mine; }
        if (sum == G) break;
        __builtin_amdgcn_s_sleep(1);
        if ((++sp & 255u) == 0u) { if (xb_ld(&bar[XB_TMO])) break; if (sp > XB_SPIN_CAP) { atomicAdd(&bar[XB_TMO], 1u); break; } }
    }
    nloc = mine > 0u ? mine : 1u; nx = cnt > 0u ? cnt : 1u;
}

__device__ __forceinline__ void xcd_barrier(const XcdBarrier& b) {
    asm volatile("s_waitcnt vmcnt(0)" ::: "memory");
    __syncthreads();
    if (threadIdx.x == 0) {
        unsigned* bar = b.bar; unsigned bx = b.x;
        asm volatile("" : "+s"(bar), "+s"(bx));
        __builtin_amdgcn_s_waitcnt(0);
        unsigned nloc = b.st[0], nx = b.st[1];
        if (nloc == 0u) { xcd_barrier_complete(bar, bx, nloc, nx); b.st[0] = nloc; b.st[1] = nx; }
        const unsigned old = xb_add(&bar[XB_XSUB(bx)], 1u);
        const unsigned gen = old / nloc;
        if (old + 1u == (gen + 1u) * nloc) {
            __builtin_amdgcn_fence(__ATOMIC_RELEASE, "agent");
            asm volatile("s_waitcnt vmcnt(0)" ::: "memory");
            const unsigned og = xb_add(&bar[XB_TOP], 1u);
            const unsigned tg = og / nx;
            if (og + 1u == (tg + 1u) * nx) xb_add(&bar[XB_TOPGEN], 1u);
            else XB_SPIN(xb_ld(&bar[XB_TOPGEN]) == tg, bar);
            __builtin_amdgcn_fence(__ATOMIC_ACQUIRE, "agent");
            xb_add(&bar[XB_XGEN(bx)], 1u);
            asm volatile("s_waitcnt vmcnt(0)" ::: "memory");
        } else {
            XB_SPIN(xb_ld(&bar[XB_XGEN(bx)]) == gen, bar);
            __builtin_amdgcn_fence(__ATOMIC_ACQUIRE, "agent");
            asm volatile("s_waitcnt vmcnt(0)" ::: "memory");
        }
    }
    __syncthreads();
}
__device__ __forceinline__ void sub_barrier(const XcdBarrier& b, unsigned target) {
    asm volatile("s_waitcnt vmcnt(0)" ::: "memory");
    __syncthreads();
    if (threadIdx.x == 0) {
        unsigned* bar = b.bar; asm volatile("" : "+s"(bar));
        __builtin_amdgcn_fence(__ATOMIC_RELEASE, "agent");
        asm volatile("s_waitcnt vmcnt(0)" ::: "memory");
        (void)xb_add(&bar[XB_SUBW], 1u);
        XB_SPIN(xb_ld(&bar[XB_SUBW]) < target, bar);
        __builtin_amdgcn_fence(__ATOMIC_ACQUIRE, "agent");
        asm volatile("s_waitcnt vmcnt(0)" ::: "memory");
    }
    __syncthreads();
}
struct Str { int row0, R; unsigned char* base; const float* xin; };
#define SPTR(s, T, OFF) ((T*)((s).base + (size_t)(OFF) * (s).R))
#define PHASE_IDX() int tid_ = threadIdx.x; asm volatile("" : "+v"(tid_)); const int tid = tid_, lane = tid & 63, wave = __builtin_amdgcn_readfirstlane(tid >> 6); \
    const int gw = blk * NWAVES + wave, NGW = G * NWAVES, gtid = blk * (NWAVES * 64) + tid, NGT = G * NWAVES * 64; (void)lane; (void)gw; (void)NGW; (void)gtid; (void)NGT;
struct TrItem { const float* W; bf16* WT; int K, N, k0, n0, roff; };
__device__ __forceinline__ void tr_load(const TrItem t, f32x4 (&v)[8], int lane) {
#pragma unroll
    for (int i = 0; i < 8; ++i) v[i] = *(const GAS f32x4*)(t.W + (size_t)(t.k0 + 8 * i + (lane >> 3)) * t.N + t.n0 + (lane & 7) * 4);
}
__device__ __forceinline__ void tr_store(const TrItem t, const f32x4 (&v)[8], LAS float* scr, int lane) {
#pragma unroll
    for (int i = 0; i < 8; ++i) { const int kk = 8 * i + (lane >> 3), c4 = (lane & 7) * 4; scr[kk * 33 + c4] = v[i].x; scr[kk * 33 + c4 + 1] = v[i].y; scr[kk * 33 + c4 + 2] = v[i].z; scr[kk * 33 + c4 + 3] = v[i].w; }
    LDS_WAIT(); asm volatile("" ::: "memory");
    const int c = lane & 7;
#pragma unroll
    for (int j = 0; j < 4; ++j) { const int n = (lane >> 3) + 8 * j; const LAS float* s = scr + (8 * c) * 33 + n;
        v4u o; o.x = pk2(s[0 * 33], s[1 * 33]); o.y = pk2(s[2 * 33], s[3 * 33]); o.z = pk2(s[4 * 33], s[5 * 33]); o.w = pk2(s[6 * 33], s[7 * 33]);
        *(GAS v4u*)(t.WT + (size_t)(t.roff + t.n0 + n) * t.K + t.k0 + 8 * c) = o; }
    LDS_WAIT(); asm volatile("" ::: "memory");
}
__device__ __forceinline__ void convert_weights(const float* w_in, const float* w_out, const float* w_up, const float* w_down, int which, unsigned char* ws, LAS unsigned char* lds, int blk, int G) {
    PHASE_IDX();
    LAS float* scr = (LAS float*)(lds + RING_OFF + wave * 16384);
    bf16* WIN = (bf16*)(ws + WS_WIN); bf16* WOUT = (bf16*)(ws + WS_WOUT); bf16* WUP = (bf16*)(ws + WS_WUP); bf16* WDN = (bf16*)(ws + WS_WDN);
    constexpr int I_IN = (DM / 64) * (INCOLS / 32), I_OUT = (DM / 64) * (DM / 32), I_UP = (DM / 64) * (NUP / 32), I_DN = (DFF / 64) * (DM / 32);
    const int lo = (which & 1) ? 0 : I_IN + I_OUT, hi = (which & 2) ? I_IN + I_OUT + I_UP + I_DN : I_IN + I_OUT;
    auto item = [&](int it) -> TrItem {
        TrItem t; int r = it;
        if (r < I_IN) { t.W = w_in; t.WT = WIN; t.K = DM; t.N = INCOLS; }
        else if ((r -= I_IN) < I_OUT) { t.W = w_out; t.WT = WOUT; t.K = DM; t.N = DM; }
        else if ((r -= I_OUT) < I_UP) { t.W = w_up; t.WT = WUP; t.K = DM; t.N = NUP; }
        else { r -= I_UP; t.W = w_down; t.WT = WDN; t.K = DFF; t.N = DM; }
        const int nblk = t.N / 32; t.k0 = 64 * (r / nblk); t.n0 = 32 * (r % nblk);
        t.roff = (t.W == w_in) ? (t.n0 >= NDNR ? NDN - NDNR : 0) : (t.W == w_up) ? ((t.n0 < DFF ? (t.n0 >> 7) * 256 + (t.n0 & 127) : ((t.n0 - DFF) >> 7) * 256 + 128 + ((t.n0 - DFF) & 127)) - t.n0) : 0;
        return t; };
    int it = lo + gw;
    f32x4 v[8], vn[8];
    TrItem cur = item(it < hi ? it : lo);
    if (it < hi) tr_load(cur, v, lane);
    while (it < hi) {
        const int nit = it + NGW; TrItem nxt = cur;
        if (nit < hi) { nxt = item(nit); tr_load(nxt, vn, lane); }
        tr_store(cur, v, scr, lane);
#pragma unroll
        for (int i = 0; i < 8; ++i) v[i] = vn[i];
        cur = nxt; it = nit;
    }
    __syncthreads();
}

__device__ __forceinline__ void norm_row(const float* xrow, const f32x4 (&g)[8], bf16* hrow, int lane) {
    f32x4 v[8]; float ss = 0.f;
#pragma unroll
    for (int j = 0; j < 8; ++j) { v[j] = __builtin_nontemporal_load((const GAS f32x4*)(xrow + 4 * lane + 256 * j)); ss += (v[j].x * v[j].x + v[j].y * v[j].y) + (v[j].z * v[j].z + v[j].w * v[j].w); }
    const float rstd = rsqrtf(wave_sum(ss) * (1.f / DM) + NORM_EPS);
#pragma unroll
    for (int j = 0; j < 8; ++j) { const f32x4 gg = g[j];
        v2u o; o.x = pk2(v[j].x * rstd * gg.x, v[j].y * rstd * gg.y); o.y = pk2(v[j].z * rstd * gg.z, v[j].w * rstd * gg.w);
        *(GAS v2u*)(hrow + 4 * lane + 256 * j) = o; }
}
template <bool XIN_F32, bool XOUT_F32>
__device__ __forceinline__ void norm_res_row(const bf16* srow, const f32x4 (&gp)[8], const void* xin, void* xout, bool has_next, const f32x4 (&gx)[8], bf16* hrow, int lane) {
    f32x4 v[8], xi[8]; float ss = 0.f;
    v4u w[4], xw[4];
#pragma unroll
    for (int j = 0; j < 4; ++j) { w[j] = *(const GAS v4u*)(srow + 8 * lane + 512 * j);
        if constexpr (XIN_F32) { xi[2 * j] = __builtin_nontemporal_load((const GAS f32x4*)((const float*)xin + 8 * lane + 512 * j)); xi[2 * j + 1] = __builtin_nontemporal_load((const GAS f32x4*)((const float*)xin + 8 * lane + 512 * j + 4)); }
        else xw[j] = __builtin_nontemporal_load((const GAS v4u*)((const bf16*)xin + 8 * lane + 512 * j)); }
#pragma unroll
    for (int j = 0; j < 4; ++j) { v[2 * j] = (f32x4){bflo(w[j].x), bfhi(w[j].x), bflo(w[j].y), bfhi(w[j].y)}; v[2 * j + 1] = (f32x4){bflo(w[j].z), bfhi(w[j].z), bflo(w[j].w), bfhi(w[j].w)};
        if constexpr (!XIN_F32) { xi[2 * j] = (f32x4){bflo(xw[j].x), bfhi(xw[j].x), bflo(xw[j].y), bfhi(xw[j].y)}; xi[2 * j + 1] = (f32x4){bflo(xw[j].z), bfhi(xw[j].z), bflo(xw[j].w), bfhi(xw[j].w)}; } }
#pragma unroll
    for (int j = 0; j < 8; ++j) ss += (v[j].x * v[j].x + v[j].y * v[j].y) + (v[j].z * v[j].z + v[j].w * v[j].w);
    const float rstd = rsqrtf(wave_sum(ss) * (1.f / DM) + NORM_EPS);
    if constexpr (XOUT_F32) asm volatile("s_waitcnt vmcnt(0)" ::: "memory");
    float ss2 = 0.f;
#pragma unroll
    for (int j = 0; j < 8; ++j) { v[j] = xi[j] + v[j] * rstd * gp[j]; ss2 += (v[j].x * v[j].x + v[j].y * v[j].y) + (v[j].z * v[j].z + v[j].w * v[j].w); }
#pragma unroll
    for (int j = 0; j < 4; ++j) {
        if constexpr (XOUT_F32) { __builtin_nontemporal_store(v[2 * j], (GAS f32x4*)((float*)xout + 8 * lane + 512 * j)); __builtin_nontemporal_store(v[2 * j + 1], (GAS f32x4*)((float*)xout + 8 * lane + 512 * j + 4)); }
        else { v4u o; o.x = pk2(v[2 * j].x, v[2 * j].y); o.y = pk2(v[2 * j].z, v[2 * j].w); o.z = pk2(v[2 * j + 1].x, v[2 * j + 1].y); o.w = pk2(v[2 * j + 1].z, v[2 * j + 1].w);
            __builtin_nontemporal_store(o, (GAS v4u*)((bf16*)xout + 8 * lane + 512 * j)); } }
    if (has_next) {
        const float rstd2 = rsqrtf(wave_sum(ss2) * (1.f / DM) + NORM_EPS);
#pragma unroll
        for (int j = 0; j < 4; ++j) { const f32x4 g0 = gx[2 * j], g1 = gx[2 * j + 1], a = v[2 * j], c = v[2 * j + 1];
            v4u o; o.x = pk2(a.x * rstd2 * g0.x, a.y * rstd2 * g0.y); o.y = pk2(a.z * rstd2 * g0.z, a.w * rstd2 * g0.w); o.z = pk2(c.x * rstd2 * g1.x, c.y * rstd2 * g1.y); o.w = pk2(c.z * rstd2 * g1.z, c.w * rstd2 * g1.w);
            *(GAS v4u*)(hrow + 8 * lane + 512 * j) = o; }
    }
}

__device__ __forceinline__ void sc_load_cx(const bf16* row, int c0, float (&cx)[16]) {
#pragma unroll
    for (int hf = 0; hf < 2; ++hf) { float cc[8], xx[8]; unpack8(*(const GAS v4u*)(row + 1024 + c0 + 8 * hf), cc); unpack8(*(const GAS v4u*)(row + 2048 + c0 + 8 * hf), xx);
#pragma unroll
        for (int i = 0; i < 8; ++i) cx[8 * hf + i] = cc[i] * xx[i]; }
}
__device__ __forceinline__ void sc_phase(const Str st, const float* conv_sc, const float* sc_norm, int blk, int G) {
    PHASE_IDX();
    const bf16* psc = SPTR(st, bf16, OFF_PSC); bf16* mix = SPTR(st, bf16, OFF_MIX);
    const int c0 = 16 * lane;
    float w0[16], w1[16], w2[16], gn[16];
#pragma unroll
    for (int i = 0; i < 16; ++i) { w0[i] = conv_sc[c0 + i]; w1[i] = conv_sc[1024 + c0 + i]; w2[i] = conv_sc[2048 + c0 + i]; gn[i] = sc_norm[c0 + i]; }
    const int n = st.R / NGW, lr0 = gw * n;
    float cxp[16], cxc[16], cxn[16];
    { int start, len; seq_bounds(st.row0 + lr0, start, len);
      if (st.row0 + lr0 > start) sc_load_cx(psc + (size_t)(lr0 - 1) * NSC, c0, cxp); else {
#pragma unroll
          for (int i = 0; i < 16; ++i) cxp[i] = 0.f; }
      sc_load_cx(psc + (size_t)lr0 * NSC, c0, cxc); }
    v4u ra[4], rb[4], ba[2], bb[2];
#define SC_LOAD_B(dst, lrow) do { const int lq_ = (lrow) < st.R ? (lrow) : st.R - 1; const bf16* rp_ = psc + (size_t)lq_ * NSC + c0; dst[0] = *(const GAS v4u*)(rp_); dst[1] = *(const GAS v4u*)(rp_ + 8); } while (0)
#define SC_LOAD_CX(dst, lrow) do { const int lq_ = (lrow) < st.R ? (lrow) : st.R - 1; const bf16* rp_ = psc + (size_t)lq_ * NSC + c0; \
        dst[0] = *(const GAS v4u*)(rp_ + 1024); dst[1] = *(const GAS v4u*)(rp_ + 1032); dst[2] = *(const GAS v4u*)(rp_ + 2048); dst[3] = *(const GAS v4u*)(rp_ + 2056); } while (0)
#define SC_STEP(k_, BC, BN, RN, RNN) do { \
        const int lr = lr0 + (k_), r = st.row0 + lr; int start, len; seq_bounds(r, start, len); \
        const bool hn = r < start + len - 1; \
        SC_LOAD_B(BN, lr + 1); SC_LOAD_CX(RNN, lr + 2); \
        { float cc[8], xx[8]; unpack8(RN[0], cc); unpack8(RN[2], xx); \
          _Pragma("unroll") for (int i = 0; i < 8; ++i) cxn[i] = cc[i] * xx[i]; \
          unpack8(RN[1], cc); unpack8(RN[3], xx); \
          _Pragma("unroll") for (int i = 0; i < 8; ++i) cxn[8 + i] = cc[i] * xx[i]; } \
        float b[16]; { float t[8]; unpack8(BC[0], t); \
            _Pragma("unroll") for (int i = 0; i < 8; ++i) b[i] = t[i]; \
            unpack8(BC[1], t); \
            _Pragma("unroll") for (int i = 0; i < 8; ++i) b[8 + i] = t[i]; } \
        float y[16]; float ss = 0.f; \
        _Pragma("unroll") for (int i = 0; i < 16; ++i) { const float v = b[i] * (w0[i] * cxp[i] + w1[i] * cxc[i] + w2[i] * (hn ? cxn[i] : 0.f)); y[i] = v; ss += v * v; } \
        ss += __shfl_xor(ss, 1); ss += __shfl_xor(ss, 2); ss += __shfl_xor(ss, 4); \
        const float rstd = rsqrtf(ss * (1.f / 128.f) + NORM_EPS); \
        v4u o0, o1; \
        o0.x = pk2(y[0] * rstd * gn[0], y[1] * rstd * gn[1]); o0.y = pk2(y[2] * rstd * gn[2], y[3] * rstd * gn[3]); o0.z = pk2(y[4] * rstd * gn[4], y[5] * rstd * gn[5]); o0.w = pk2(y[6] * rstd * gn[6], y[7] * rstd * gn[7]); \
        o1.x = pk2(y[8] * rstd * gn[8], y[9] * rstd * gn[9]); o1.y = pk2(y[10] * rstd * gn[10], y[11] * rstd * gn[11]); o1.z = pk2(y[12] * rstd * gn[12], y[13] * rstd * gn[13]); o1.w = pk2(y[14] * rstd * gn[14], y[15] * rstd * gn[15]); \
        bf16* orow = mix + (size_t)lr * DM + 1024 + c0; \
        *(GAS v4u*)(orow) = o0; *(GAS v4u*)(orow + 8) = o1; \
        _Pragma("unroll") for (int i = 0; i < 16; ++i) { cxp[i] = hn ? cxc[i] : 0.f; cxc[i] = cxn[i]; }     \
        } while (0)
    SC_LOAD_B(ba, lr0); SC_LOAD_CX(ra, lr0 + 1);
    for (int k = 0; k < n; k += 2) { SC_STEP(k, ba, bb, ra, rb); SC_STEP(k + 1, bb, ba, rb, ra); }
#undef SC_STEP
#undef SC_LOAD_B
#undef SC_LOAD_CX
}

__device__ __forceinline__ void glu_fixup_phase(const Str st, const float* conv_ffn, int blk, int G) {
    PHASE_IDX();
    const float* SA = SPTR(st, float, OFF_SA); const float* SB = SPTR(st, float, OFF_SB); bf16* hmid = SPTR(st, bf16, OFF_HMID);
    const int NT = st.R / 256; constexpr int PER = DFF / 4;
    for (int it = gtid; it < NT * 2 * PER; it += NGT) {
        const int c4 = (it % PER) * 4, e = (it / PER) & 1, pm = it / (2 * PER);
        const int lr = pm * 256 + (e ? 255 : 0), r = st.row0 + lr; int start, len; seq_bounds(r, start, len);
        f32x4 pv, cv, nv, bv;
        if (e == 0) { cv = *(const GAS f32x4*)(SA + ((size_t)pm * 4 + 0) * DFF + c4); nv = *(const GAS f32x4*)(SA + ((size_t)pm * 4 + 1) * DFF + c4); bv = *(const GAS f32x4*)(SB + ((size_t)pm * 2) * DFF + c4);
            pv = (r > start) ? *(const GAS f32x4*)(SA + ((size_t)(pm - 1) * 4 + 3) * DFF + c4) : (f32x4){0.f, 0.f, 0.f, 0.f}; }
        else { pv = *(const GAS f32x4*)(SA + ((size_t)pm * 4 + 2) * DFF + c4); cv = *(const GAS f32x4*)(SA + ((size_t)pm * 4 + 3) * DFF + c4); bv = *(const GAS f32x4*)(SB + ((size_t)pm * 2 + 1) * DFF + c4);
            nv = (r < start + len - 1) ? *(const GAS f32x4*)(SA + ((size_t)(pm + 1) * 4 + 0) * DFF + c4) : (f32x4){0.f, 0.f, 0.f, 0.f}; }
        const f32x4 k0 = *(const GAS f32x4*)(conv_ffn + c4), k1 = *(const GAS f32x4*)(conv_ffn + DFF + c4), k2 = *(const GAS f32x4*)(conv_ffn + 2 * DFF + c4);
        float o[4];
#pragma unroll
        for (int j = 0; j < 4; ++j) { const float s = k0[j] * pv[j] + k1[j] * cv[j] + k2[j] * nv[j]; o[j] = siluf(s) * bv[j]; }
        v2u w; w.x = cvt2(o[0], o[1]); w.y = cvt2(o[2], o[3]);
        *(GAS v2u*)(hmid + (size_t)lr * DFF + c4) = w;
    }
}

typedef short bf16x8 __attribute__((ext_vector_type(8)));
typedef short s16x4 __attribute__((ext_vector_type(4)));
#define MFMA16(a, b, c) __builtin_amdgcn_mfma_f32_16x16x32_bf16((a), (b), (c), 0, 0, 0)
__device__ __forceinline__ v2u pack4(const f32x4 a) { v2u r; r.x = cvt2(a[0], a[1]); r.y = cvt2(a[2], a[3]); return r; }
__device__ __forceinline__ f32x4 unpack4(const v2u w) { return (f32x4){bflo(w.x), bfhi(w.x), bflo(w.y), bfhi(w.y)}; }
__device__ __forceinline__ bf16x8 pack_pair(const f32x4 a, const f32x4 b) { v4u p; p.x = cvt2(a[0], a[1]); p.y = cvt2(a[2], a[3]); p.z = cvt2(b[0], b[1]); p.w = cvt2(b[2], b[3]); return __builtin_bit_cast(bf16x8, p); }
__device__ __forceinline__ bf16x8 frag_plain(const LAS unsigned char* p) { return *(const LAS bf16x8*)p; }
__device__ __forceinline__ bf16x8 frag_2x8(const LAS unsigned char* p0, const LAS unsigned char* p1) { const v2u a = *(const LAS v2u*)p0, b = *(const LAS v2u*)p1; v4u r; r.x = a.x; r.y = a.y; r.z = b.x; r.w = b.y; return __builtin_bit_cast(bf16x8, r); }
__device__ __forceinline__ bf16x8 frag_tr(const LAS unsigned char* p0, const LAS unsigned char* p1) {
    const s16x4 a = __builtin_amdgcn_ds_read_tr16_b64_v4i16((LAS s16x4*)p0), b = __builtin_amdgcn_ds_read_tr16_b64_v4i16((LAS s16x4*)p1);
    return __builtin_shufflevector(a, b, 0, 1, 2, 3, 4, 5, 6, 7);
}
constexpr int PQB = 272, PXB = 144;
constexpr int TILE_Q = 64 * PQB, TILE_X = 64 * PXB;
constexpr int NUNIT = (TT / 64) * NHEAD;
constexpr size_t CHT = 64 * 128;
constexpr int PL_Q = 0, PL_K = TILE_Q, PL_V = 2 * TILE_Q, PL_MAT = 3 * TILE_Q;
constexpr int PL_GC = PL_MAT + 8 * TILE_X, PL_BE = PL_GC + 512, PL_CW = EXTRA_OFF, PL_END = PL_BE + 512;
static_assert(PL_END <= RING_BYTES, "prep LDS");

struct DeltaBufs { bf16* QN; bf16* KN; bf16* W0; bf16* W1; bf16* UT0; bf16* UT1; bf16* AQ0; bf16* AQ1; float* GC0; float* GC1; };
__device__ __forceinline__ DeltaBufs delta_bufs(const Str s) { return DeltaBufs{SPTR(s, bf16, OFF_QN), SPTR(s, bf16, OFF_KN), SPTR(s, bf16, OFF_W0), SPTR(s, bf16, OFF_W1), SPTR(s, bf16, OFF_UT0), SPTR(s, bf16, OFF_UT1), SPTR(s, bf16, OFF_AQ0), SPTR(s, bf16, OFF_AQ1), SPTR(s, float, OFF_GC0), SPTR(s, float, OFF_GC1)}; }

#define SCHED_FENCE() __builtin_amdgcn_sched_barrier(0)
template <bool DO_R, bool DO_X>
__device__ __forceinline__ void neumann_step(const LAS unsigned char* Rin, const LAS unsigned char* Xin, f32x4 (&accR)[2][2], f32x4 (&accX)[2][2], int jb, int ib, int c, int g, int q, int p) {
    bf16x8 A[2][2], BR[2][2], BX[2][2];
#pragma unroll
    for (int ks = 0; ks < 2; ++ks) {
#pragma unroll
        for (int a = 0; a < 2; ++a) { const LAS unsigned char* y = Xin + (32 * ks + 8 * g + q) * PXB + (32 * jb + 16 * a + 4 * p) * 2; A[ks][a] = frag_tr(y, y + 4 * PXB); }
#pragma unroll
        for (int b = 0; b < 2; ++b) { if (DO_R) BR[ks][b] = frag_plain(Rin + (32 * ib + 16 * b + c) * PXB + (32 * ks + 8 * g) * 2); if (DO_X) BX[ks][b] = frag_plain(Xin + (32 * ib + 16 * b + c) * PXB + (32 * ks + 8 * g) * 2); }
    }
#pragma unroll
    for (int a = 0; a < 2; ++a)
#pragma unroll
        for (int b = 0; b < 2; ++b) { if (DO_R) accR[a][b] = unpack4(*(const LAS v2u*)(Rin + (32 * ib + 16 * b + c) * PXB + (32 * jb + 16 * a + 4 * g) * 2)); accX[a][b] = (f32x4){0.f, 0.f, 0.f, 0.f}; }
    SCHED_FENCE();
#pragma unroll
    for (int ks = 0; ks < 2; ++ks)
#pragma unroll
        for (int a = 0; a < 2; ++a)
#pragma unroll
            for (int b = 0; b < 2; ++b) { if (DO_R) accR[a][b] = MFMA16(A[ks][a], BR[ks][b], accR[a][b]); if (DO_X) accX[a][b] = MFMA16(A[ks][a], BX[ks][b], accX[a][b]); }
    SCHED_FENCE();
}
__device__ __forceinline__ void mat_store(LAS unsigned char* O, const f32x4 (&acc)[2][2], int jb, int ib, int c, int g) {
#pragma unroll
    for (int a = 0; a < 2; ++a)
#pragma unroll
        for (int b = 0; b < 2; ++b) *(LAS v2u*)(O + (32 * ib + 16 * b + c) * PXB + (32 * jb + 16 * a + 4 * g) * 2) = pack4(acc[a][b]);
}

__device__ __forceinline__ void delta_prep(const Str st, const float* conv_qkv, const float* a_log, const float* dt_bias, LAS unsigned char* lds, int blk, int G) {
    PHASE_IDX();
    const bf16* pdn = SPTR(st, bf16, OFF_PDN); const DeltaBufs B = delta_bufs(st); const int row0 = st.row0;
    const int head = blk & 7, dirn = wave >> 2, wq = wave & 3, jb = wq >> 1, ib = wq & 1, c = lane & 15, g = lane >> 4, q = c >> 2, p = lane & 3;
    LAS float* CW = (LAS float*)(lds + PL_CW);
    for (int i = tid; i < 3 * 384; i += NWAVES * 64) { const int tap = i / 384, ch = i % 384; CW[i] = conv_qkv[tap * NQKV + (ch >> 7) * 1024 + head * 128 + (ch & 127)]; }
    LAS float* GCS = (LAS float*)(lds + PL_GC); LAS float* BES = (LAS float*)(lds + PL_BE);
    LAS unsigned char* MAT = lds + PL_MAT + dirn * 4 * TILE_X;
    LAS unsigned char* XA = MAT; LAS unsigned char* XB = MAT + TILE_X; LAS unsigned char* RA = MAT + 2 * TILE_X; LAS unsigned char* RB = MAT + 3 * TILE_X;
    const int gd = (tid >> 6) & 1;
    const float Ae = __expf(a_log[gd * 8 + head]), dtb = dt_bias[gd * 8 + head];
    bf16* Wg = dirn ? B.W1 : B.W0; bf16* UTg = dirn ? B.UT1 : B.UT0; bf16* AQg = dirn ? B.AQ1 : B.AQ0;
    const float SCALE = 0.08838834764831845f;
    const int gstep = G >> 3, gend = st.R / 64;
    constexpr int RPB = 784;
    LAS unsigned char* RAWT = lds + PL_MAT;
    static_assert(66 * RPB <= 8 * TILE_X, "raw tile fits the matrix region");
    v4u raw[7]; unsigned short ga = 0, gb = 0;
#define RAW_LOAD(gch_) do { const int t0_ = (gch_) * 64; int st_, ln_; seq_bounds(row0 + t0_, st_, ln_); st_ -= row0; int ty_ = tid; asm volatile("" : "+v"(ty_)); \
        _Pragma("unroll") for (int k = 0; k < 6; ++k) { const int i = ty_ + 512 * k, row = i / 48, cg = i % 48; \
            raw[k] = *(const GAS v4u*)(pdn + (size_t)(t0_ + row) * NDN + (cg >> 4) * 1024 + head * 128 + (cg & 15) * 8); } \
        if (tid < 96) { const int hr = tid / 48, cg = tid % 48, t = hr ? t0_ + 64 : t0_ - 1; const bool ok = hr ? (t < st_ + ln_) : (t >= st_); \
            raw[6] = ok ? *(const GAS v4u*)(pdn + (size_t)t * NDN + (cg >> 4) * 1024 + head * 128 + (cg & 15) * 8) : (v4u){0u, 0u, 0u, 0u}; } \
        if (tid < 128) { ga = pdn[(size_t)(t0_ + lane) * NDN + 4096 + gd * 8 + head]; gb = pdn[(size_t)(t0_ + lane) * NDN + 4096 + 16 + gd * 8 + head]; } } while (0)
    RAW_LOAD(blk >> 3);
    LDS_BAR();
    for (int gch = blk >> 3; gch < gend; gch += gstep) {
        const int u = gch * 8 + head;
        int tz = tid; asm volatile("" : "+v"(tz));
#pragma unroll
        for (int k = 0; k < 6; ++k) { const int i = tz + 512 * k, row = i / 48, cg = i % 48; *(LAS v4u*)(RAWT + (row + 1) * RPB + cg * 16) = raw[k]; }
        if (tid < 96) { const int hr = tid / 48, cg = tid % 48; *(LAS v4u*)(RAWT + (hr ? 65 : 0) * RPB + cg * 16) = raw[6]; }
        const unsigned short ga_c = ga, gb_c = gb;
        LDS_BAR();
        if (gch + gstep < gend) RAW_LOAD(gch + gstep);
#pragma unroll
        for (int k = 0; k < 6; ++k) {
            const int i = tz + 512 * k, row = i / 48, cg = i % 48, tensor = cg >> 4, c8 = (cg & 15) * 8;
            float xm[8], x0[8], xp[8];
            unpack8(*(const LAS v4u*)(RAWT + row * RPB + cg * 16), xm); unpack8(*(const LAS v4u*)(RAWT + (row + 1) * RPB + cg * 16), x0); unpack8(*(const LAS v4u*)(RAWT + (row + 2) * RPB + cg * 16), xp);
            float s[8]; float ss = 0.f;
            const LAS float* cw = CW + tensor * 128 + c8;
#pragma unroll
            for (int e = 0; e < 8; ++e) { const float v = cw[e] * xm[e] + cw[384 + e] * x0[e] + cw[768 + e] * xp[e]; s[e] = siluf(v); ss += s[e] * s[e]; }
            ss += __shfl_xor(ss, 1); ss += __shfl_xor(ss, 2); ss += __shfl_xor(ss, 4); ss += __shfl_xor(ss, 8);
            const float rn = tensor < 2 ? rsqrtf(ss + L2_EPS) : 1.f;
            v4u o; o.x = cvt2(s[0] * rn, s[1] * rn); o.y = cvt2(s[2] * rn, s[3] * rn); o.z = cvt2(s[4] * rn, s[5] * rn); o.w = cvt2(s[6] * rn, s[7] * rn);
            *(LAS v4u*)(lds + tensor * TILE_Q + row * PQB + c8 * 2) = o;
            if (tensor == 0) *(GAS v4u*)(B.QN + (size_t)u * CHT + row * 128 + c8) = o;
            if (tensor == 1) *(GAS v4u*)(B.KN + (size_t)u * CHT + row * 128 + c8) = o;
        }
        if (tid < 128) {
            const float a = bf1(ga_c), b = bf1(gb_c);
            const float xx = a + dtb, sp = xx > 20.f ? xx : log1pf(__expf(xx));
            float x = -Ae * sp;
#pragma unroll
            for (int o = 1; o < 64; o <<= 1) { const float up = __shfl_up(x, o), dn = __shfl_down(x, o); if (gd == 0) { if (lane >= o) x += up; } else { if (lane + o < 64) x += dn; } }
            GCS[gd * 64 + lane] = x; BES[gd * 64 + lane] = __builtin_amdgcn_rcpf(1.f + __expf(-b));
            const float gtot = __shfl(x, gd ? 0 : 63);
            float* gcp = (gd ? B.GC1 : B.GC0) + (size_t)u * 192;
            gcp[lane] = 0.08838834764831845f * __expf(x); gcp[64 + lane] = __expf(gtot - x); if (lane == 0) gcp[128] = __expf(gtot);
        }
        LDS_BAR();
        {
            f32x4 kk[2][2], kq[2][2];
#pragma unroll
            for (int a = 0; a < 2; ++a)
#pragma unroll
                for (int b = 0; b < 2; ++b) { kk[a][b] = (f32x4){0.f, 0.f, 0.f, 0.f}; kq[a][b] = (f32x4){0.f, 0.f, 0.f, 0.f}; }
#pragma unroll
            for (int kh = 0; kh < 2; ++kh) {
                bf16x8 A[2][2], Bk[2][2], Bq[2][2];
#pragma unroll
                for (int k2 = 0; k2 < 2; ++k2) { const int ks = 2 * kh + k2;
#pragma unroll
                    for (int a = 0; a < 2; ++a) A[k2][a] = frag_plain(lds + PL_K + (32 * jb + 16 * a + c) * PQB + (32 * ks + 8 * g) * 2);
#pragma unroll
                    for (int b = 0; b < 2; ++b) { Bk[k2][b] = frag_plain(lds + PL_K + (32 * ib + 16 * b + c) * PQB + (32 * ks + 8 * g) * 2); Bq[k2][b] = frag_plain(lds + PL_Q + (32 * ib + 16 * b + c) * PQB + (32 * ks + 8 * g) * 2); }
                }
                SCHED_FENCE();
#pragma unroll
                for (int k2 = 0; k2 < 2; ++k2)
#pragma unroll
                    for (int a = 0; a < 2; ++a)
#pragma unroll
                        for (int b = 0; b < 2; ++b) { kk[a][b] = MFMA16(A[k2][a], Bk[k2][b], kk[a][b]); kq[a][b] = MFMA16(A[k2][a], Bq[k2][b], kq[a][b]); }
                SCHED_FENCE();
            }
#pragma unroll
            for (int b = 0; b < 2; ++b) {
                const int i = 32 * ib + 16 * b + c; const float gci = GCS[dirn * 64 + i], bei = BES[dirn * 64 + i];
                v2u aqp[2];
#pragma unroll
                for (int a = 0; a < 2; ++a) {
                    const int j0 = 32 * jb + 16 * a + 4 * g; const f32x4 gcj = *(const LAS f32x4*)(GCS + dirn * 64 + j0);
                    f32x4 x1, r0, aq;
#pragma unroll
                    for (int r = 0; r < 4; ++r) { const int j = j0 + r; const bool strict = dirn ? (i < j) : (i > j), incl = strict || (i == j);
                        const float dec = incl ? __expf(gci - gcj[r]) : 0.f; const float av = strict ? bei * kk[a][b][r] * dec : 0.f;
                        x1[r] = -av; r0[r] = (i == j) ? 1.f : -av; aq[r] = kq[a][b][r] * SCALE * dec; }
                    *(LAS v2u*)(XA + i * PXB + j0 * 2) = pack4(x1); *(LAS v2u*)(RA + i * PXB + j0 * 2) = pack4(r0);
                    aqp[a] = pack4(aq);
                }
                *(GAS v4u*)(AQg + (size_t)u * 4096 + i * 64 + 32 * jb + 8 * g) = (v4u){aqp[0].x, aqp[0].y, aqp[1].x, aqp[1].y};
            }
        }
        LDS_BAR();
        f32x4 acc[2][2], acc2[2][2];
        neumann_step<false, true>(RA, XA, acc, acc2, jb, ib, c, g, q, p); mat_store(XB, acc2, jb, ib, c, g);
        LDS_BAR();
        neumann_step<true, true>(RA, XB, acc, acc2, jb, ib, c, g, q, p); mat_store(RB, acc, jb, ib, c, g); mat_store(XA, acc2, jb, ib, c, g);
        LDS_BAR();
        neumann_step<true, true>(RB, XA, acc, acc2, jb, ib, c, g, q, p); mat_store(RA, acc, jb, ib, c, g); mat_store(XB, acc2, jb, ib, c, g);
        LDS_BAR();
        neumann_step<true, true>(RA, XB, acc, acc2, jb, ib, c, g, q, p); mat_store(RB, acc, jb, ib, c, g); mat_store(XA, acc2, jb, ib, c, g);
        LDS_BAR();
        neumann_step<true, true>(RB, XA, acc, acc2, jb, ib, c, g, q, p); mat_store(RA, acc, jb, ib, c, g); mat_store(XB, acc2, jb, ib, c, g);
        LDS_BAR();
        neumann_step<true, false>(RA, XB, acc, acc2, jb, ib, c, g, q, p);
#pragma unroll
        for (int a = 0; a < 2; ++a) { const int j0 = 32 * jb + 16 * a + 4 * g; const f32x4 gcj = *(const LAS f32x4*)(GCS + dirn * 64 + j0), bej = *(const LAS f32x4*)(BES + dirn * 64 + j0);
#pragma unroll
            for (int b = 0; b < 2; ++b) { f32x4 t1, t2;
#pragma unroll
                for (int r = 0; r < 4; ++r) { t1[r] = acc[a][b][r] * bej[r]; t2[r] = t1[r] * __expf(gcj[r]); }
                acc[a][b] = t1; acc2[a][b] = t2; } }
        mat_store(RB, acc, jb, ib, c, g); mat_store(XA, acc2, jb, ib, c, g);
        LDS_BAR();
        {
            bf16x8 At[4][2], Bv[2][2];
#pragma unroll
            for (int a = 0; a < 4; ++a)
#pragma unroll
                for (int ks = 0; ks < 2; ++ks) At[a][ks] = frag_plain(RB + (16 * a + c) * PXB + (32 * ks + 8 * g) * 2);
#pragma unroll
            for (int et = 0; et < 2; ++et)
#pragma unroll
                for (int ks = 0; ks < 2; ++ks) { const LAS unsigned char* v = lds + PL_V + (32 * ks + 8 * g + q) * PQB + (32 * wq + 16 * et + 4 * p) * 2; Bv[et][ks] = frag_tr(v, v + 4 * PQB); }
            SCHED_FENCE();
            f32x4 o[2][4];
#pragma unroll
            for (int et = 0; et < 2; ++et)
#pragma unroll
                for (int a = 0; a < 4; ++a) { o[et][a] = (f32x4){0.f, 0.f, 0.f, 0.f};
#pragma unroll
                    for (int ks = 0; ks < 2; ++ks) o[et][a] = MFMA16(At[a][ks], Bv[et][ks], o[et][a]); }
            SCHED_FENCE();
#pragma unroll
            for (int et = 0; et < 2; ++et)
#pragma unroll
                for (int s = 0; s < 2; ++s) { const v2u lo = pack4(o[et][2 * s]), hi = pack4(o[et][2 * s + 1]);
                    *(GAS v4u*)(UTg + (size_t)u * CHT + (32 * wq + 16 * et + c) * 64 + 32 * s + 8 * g) = (v4u){lo.x, lo.y, hi.x, hi.y}; }
        }
        {
            bf16x8 Ak[2][2], Bt[4][2];
#pragma unroll
            for (int dt = 0; dt < 2; ++dt)
#pragma unroll
                for (int ks = 0; ks < 2; ++ks) { const LAS unsigned char* kp = lds + PL_K + (32 * ks + 8 * g + q) * PQB + (32 * wq + 16 * dt + 4 * p) * 2; Ak[dt][ks] = frag_tr(kp, kp + 4 * PQB); }
#pragma unroll
            for (int b = 0; b < 4; ++b)
#pragma unroll
                for (int ks = 0; ks < 2; ++ks) Bt[b][ks] = frag_plain(XA + (16 * b + c) * PXB + (32 * ks + 8 * g) * 2);
            SCHED_FENCE();
            f32x4 o[2][4];
#pragma unroll
            for (int dt = 0; dt < 2; ++dt)
#pragma unroll
                for (int b = 0; b < 4; ++b) { o[dt][b] = (f32x4){0.f, 0.f, 0.f, 0.f};
#pragma unroll
                    for (int ks = 0; ks < 2; ++ks) o[dt][b] = MFMA16(Ak[dt][ks], Bt[b][ks], o[dt][b]); }
            SCHED_FENCE();
#pragma unroll
            for (int b = 0; b < 4; ++b) { const v2u lo = pack4(o[0][b]), hi = pack4(o[1][b]);
                *(GAS v4u*)(Wg + (size_t)u * CHT + (16 * b + c) * 128 + 32 * wq + 8 * g) = (v4u){lo.x, lo.y, hi.x, hi.y}; }
        }
        LDS_BAR();
    }
#undef RAW_LOAD
}

constexpr int SQB = 272, SKB = 288, SAB = 160, SUB = 144;
constexpr int SL_W = 0, SL_Q = 64 * SQB, SL_K = 2 * 64 * SQB, SL_A = SL_K + 64 * SKB, SL_G = SL_A + 64 * SAB, SL_U = SL_G + 768, SL_BUF = SL_U + 64 * SUB;
static_assert(2 * SL_BUF <= RING_BYTES, "scan LDS");
constexpr int NLD = 19;
__device__ __forceinline__ void delta_scan(const Str st, LAS unsigned char* lds, int blk, int G) {
    if (blk < 0 || blk >= 64) return;
    PHASE_IDX();
    const DeltaBufs B = delta_bufs(st);
    const int sid = (blk & 7) | ((blk >> 4) << 3), half = (blk >> 3) & 1, seq = sid >> 4, dirn = (sid >> 3) & 1, head = sid & 7;
    const int len = st.R >> 1, start = seq * len, NC = len / 64, gch0 = start / 64;
    const bf16* Wg = dirn ? B.W1 : B.W0; bf16* UTg = dirn ? B.UT1 : B.UT0; const bf16* AQg = dirn ? B.AQ1 : B.AQ0; const float* GCg = dirn ? B.GC1 : B.GC0;
    const float SCALE = 0.08838834764831845f;
#define UNIT_OF(ci) ((size_t)((gch0 + (dirn ? NC - 1 - (ci) : (ci))) * 8 + head))
    if (wave >= 4) {
#define GLD(dst, base, voff, imm) asm volatile("s_nop 4\n\tglobal_load_dwordx4 %0, %1, %2 offset:" #imm : "=v"(dst) : "v"(voff), "s"(base) : "memory")
        const int lu = tid & 127;
#define PIECE_WQK(k_, h_) const int x = 512 * (h_) + lu + 128 * (k_), row = x >> 4, cc = x & 15
#define PIECE_A(k_, h_)   const int x = 256 * (h_) + lu + 128 * (k_), row = x >> 3, cc = x & 7
#define WR_WQK(b_, k_, h_, RW, RQ, RK) do { PIECE_WQK(k_, h_); *(LAS v4u*)(b_ + SL_W + row * SQB + cc * 16) = RW; *(LAS v4u*)(b_ + SL_K + row * SKB + cc * 16) = RK; \
            const int pb2 = ((cc & 12) * 8 + 16 * (cc & 1) + 4 * ((cc >> 1) & 1)) * 2; *(LAS v2u*)(b_ + SL_Q + row * SQB + pb2) = (v2u){RQ.x, RQ.y}; *(LAS v2u*)(b_ + SL_Q + row * SQB + pb2 + 16) = (v2u){RQ.z, RQ.w}; } while (0)
        if (wave >= 6) {
            const int oh = half ^ 1;
            const unsigned vo = (unsigned)lu * 16u + 4096u + 8192u * (unsigned)oh, voa = (unsigned)lu * 16u + 4096u + 4096u * (unsigned)oh;
            v4u R[14];
#define LO_ISSUE(ci) do { const size_t u_ = UNIT_OF(ci); const bf16* pw_ = Wg + u_ * CHT; const bf16* pq_ = B.QN + u_ * CHT; const bf16* pk_ = B.KN + u_ * CHT; const bf16* pa_ = AQg + u_ * 4096; \
                GLD(R[0], pw_, vo, -4096); GLD(R[4], pq_, vo, -4096); GLD(R[8], pk_, vo, -4096); GLD(R[1], pw_, vo, -2048); GLD(R[5], pq_, vo, -2048); GLD(R[9], pk_, vo, -2048); \
                GLD(R[2], pw_, vo, 0); GLD(R[6], pq_, vo, 0); GLD(R[10], pk_, vo, 0); GLD(R[3], pw_, vo, 2048); GLD(R[7], pq_, vo, 2048); GLD(R[11], pk_, vo, 2048); \
                GLD(R[12], pa_, voa, -4096); GLD(R[13], pa_, voa, -2048); } while (0)
#define LO_WAIT0() asm volatile("s_waitcnt vmcnt(0)" : "+v"(R[0]), "+v"(R[1]), "+v"(R[2]), "+v"(R[3]), "+v"(R[4]), "+v"(R[5]), "+v"(R[6]), "+v"(R[7]), "+v"(R[8]), "+v"(R[9]), "+v"(R[10]), "+v"(R[11]), "+v"(R[12]), "+v"(R[13]) :: "memory")
#define LO_WRITE(buf) do { LAS unsigned char* b_ = lds + (buf) * SL_BUF; \
                _Pragma("unroll") for (int k = 0; k < 4; ++k) WR_WQK(b_, k, oh, R[k], R[4 + k], R[8 + k]); \
                _Pragma("unroll") for (int k = 0; k < 2; ++k) { PIECE_A(k, oh); *(LAS v4u*)(b_ + SL_A + row * SAB + cc * 16) = R[12 + k]; } } while (0)
            LO_ISSUE(0); LO_WAIT0(); LO_WRITE(0);
            LDS_BAR();
            for (int ci = 0; ci < NC; ci += 2) {
                { const int cn = ci + 1 < NC ? ci + 1 : NC - 1; LO_ISSUE(cn); } LO_WAIT0(); LO_WRITE(1);
                LDS_BAR();
                { const int cn = ci + 2 < NC ? ci + 2 : NC - 1; LO_ISSUE(cn); } LO_WAIT0(); LO_WRITE(0);
                LDS_BAR();
            }
#undef LO_ISSUE
#undef LO_WAIT0
#undef LO_WRITE
        } else {
            const unsigned vo = (unsigned)lu * 16u + 4096u + 8192u * (unsigned)half, voa = (unsigned)lu * 16u + 4096u + 4096u * (unsigned)half, vou = (unsigned)lu * 16u + 4096u, vog = (unsigned)(lu < 48 ? lu : 47) * 16u;
            constexpr int NOWN = 19;
            v4u RA[NOWN], RB[NOWN];
#define LW_ISSUE(ci, R) do { const size_t u_ = UNIT_OF(ci); const bf16* pw_ = Wg + u_ * CHT; const bf16* pq_ = B.QN + u_ * CHT; const bf16* pk_ = B.KN + u_ * CHT; \
                const bf16* pa_ = AQg + u_ * 4096; const bf16* pu_ = UTg + u_ * CHT + half * 4096; const float* pg_ = GCg + u_ * 192; \
                GLD(R[0], pw_, vo, -4096); GLD(R[4], pq_, vo, -4096); GLD(R[8], pk_, vo, -4096); GLD(R[1], pw_, vo, -2048); GLD(R[5], pq_, vo, -2048); GLD(R[9], pk_, vo, -2048); \
                GLD(R[2], pw_, vo, 0); GLD(R[6], pq_, vo, 0); GLD(R[10], pk_, vo, 0); GLD(R[3], pw_, vo, 2048); GLD(R[7], pq_, vo, 2048); GLD(R[11], pk_, vo, 2048); \
                GLD(R[12], pa_, voa, -4096); GLD(R[13], pa_, voa, -2048); \
                GLD(R[14], pu_, vou, -4096); GLD(R[15], pu_, vou, -2048); GLD(R[16], pu_, vou, 0); GLD(R[17], pu_, vou, 2048); \
                GLD(R[18], pg_, vog, 0); } while (0)
#define LW_WAIT(N, R) asm volatile("s_waitcnt vmcnt(" #N ")" : "+v"(R[0]), "+v"(R[1]), "+v"(R[2]), "+v"(R[3]), "+v"(R[4]), "+v"(R[5]), "+v"(R[6]), "+v"(R[7]), "+v"(R[8]), \
                "+v"(R[9]), "+v"(R[10]), "+v"(R[11]), "+v"(R[12]), "+v"(R[13]), "+v"(R[14]), "+v"(R[15]), "+v"(R[16]), "+v"(R[17]), "+v"(R[18]) :: "memory")
#define LW_WRITE(buf, R) do { LAS unsigned char* b_ = lds + (buf) * SL_BUF; \
                _Pragma("unroll") for (int k = 0; k < 4; ++k) WR_WQK(b_, k, half, R[k], R[4 + k], R[8 + k]); \
                _Pragma("unroll") for (int k = 0; k < 2; ++k) { PIECE_A(k, half); *(LAS v4u*)(b_ + SL_A + row * SAB + cc * 16) = R[12 + k]; } \
                _Pragma("unroll") for (int k = 0; k < 4; ++k) { const int x = lu + 128 * k, row = x >> 3, cc = x & 7; *(LAS v4u*)(b_ + SL_U + row * SUB + cc * 16) = R[14 + k]; } \
                if (lu < 48) *(LAS v4u*)(b_ + SL_G + lu * 16) = R[18]; } while (0)
            LW_ISSUE(0, RA); LW_WAIT(0, RA); LW_WRITE(0, RA);
            LW_ISSUE(1, RA); LW_ISSUE(2, RB);
            LDS_BAR();
            for (int ci = 0; ci < NC; ci += 2) {
                LW_WAIT(19, RA);
                LW_WRITE(1, RA); { const int cn = ci + 3 < NC ? ci + 3 : NC - 1; LW_ISSUE(cn, RA); }
                LDS_BAR();
                LW_WAIT(19, RB);
                LW_WRITE(0, RB); { const int cn = ci + 4 < NC ? ci + 4 : NC - 1; LW_ISSUE(cn, RB); }
                LDS_BAR();
            }
            asm volatile("s_waitcnt vmcnt(0)" ::: "memory");
#undef LW_ISSUE
#undef LW_WAIT
#undef LW_WRITE
        }
#undef GLD
#undef PIECE_WQK
#undef PIECE_A
#undef WR_WQK
    } else {
        const int c = lane & 15, g = lane >> 4, q = c >> 2, p = lane & 3, e0 = 64 * half + 16 * wave;
        f32x4 S[8];
#pragma unroll
        for (int i = 0; i < 8; ++i) S[i] = (f32x4){0.f, 0.f, 0.f, 0.f};
        const int offA = c * SQB + 16 * g, offX = c * SAB + 16 * g, offT = (4 * g + q) * SKB + 8 * p;
#define LDWQ(ks, AW, AQ) do { _Pragma("unroll") for (int a = 0; a < 4; ++a) { AW[a] = frag_plain(b_ + SL_W + offA + a * 16 * SQB + (ks) * 64); AQ[a] = frag_plain(b_ + SL_Q + offA + a * 16 * SQB + (ks) * 64); } } while (0)
#define MMWQ(ks, AW, AQ) do { _Pragma("unroll") for (int a = 0; a < 4; ++a) { vw[a] = MFMA16(AW[a], Sb[ks], vw[a]); qs[a] = MFMA16(AQ[a], Sb[ks], qs[a]); } } while (0)
#define LDKN(dt0, AK) do { _Pragma("unroll") for (int d = 0; d < 4; ++d) _Pragma("unroll") for (int ks = 0; ks < 2; ++ks) { const LAS unsigned char* kp = b_ + SL_K + offT + ks * 32 * SKB + ((dt0) + d) * 32; AK[d][ks] = frag_tr(kp, kp + 16 * SKB); } } while (0)
#define MMKN(dt0, AK) do { _Pragma("unroll") for (int d = 0; d < 4; ++d) { S[(dt0) + d] = S[(dt0) + d] * gl; _Pragma("unroll") for (int ks = 0; ks < 2; ++ks) S[(dt0) + d] = MFMA16(AK[d][ks], Vd[ks], S[(dt0) + d]); } } while (0)
        LDS_BAR();
        for (int ci = 0; ci < NC; ++ci) {
            const size_t u = UNIT_OF(ci);
            const LAS unsigned char* b_ = lds + (ci & 1) * SL_BUF;
            bf16x8 Aw0[4], Aq0[4], Aw1[4], Aq1[4];
            LDWQ(0, Aw0, Aq0);
            bf16x8 Sb[4];
#pragma unroll
            for (int ks = 0; ks < 4; ++ks) Sb[ks] = pack_pair(S[2 * ks], S[2 * ks + 1]);
            f32x4 vw[4], qs[4];
#pragma unroll
            for (int a = 0; a < 4; ++a) { vw[a] = (f32x4){0.f, 0.f, 0.f, 0.f}; qs[a] = (f32x4){0.f, 0.f, 0.f, 0.f}; }
            LDWQ(1, Aw1, Aq1); SCHED_FENCE();
            MMWQ(0, Aw0, Aq0); SCHED_FENCE();
            LDWQ(2, Aw0, Aq0); SCHED_FENCE();
            MMWQ(1, Aw1, Aq1); SCHED_FENCE();
            LDWQ(3, Aw1, Aq1); SCHED_FENCE();
            MMWQ(2, Aw0, Aq0); SCHED_FENCE();
            bf16x8 Aa[4][2], Ak[4][2];
#pragma unroll
            for (int a = 0; a < 4; ++a)
#pragma unroll
                for (int ks = 0; ks < 2; ++ks) Aa[a][ks] = frag_plain(b_ + SL_A + offX + a * 16 * SAB + ks * 64);
            const LAS float* GCb = (const LAS float*)(b_ + SL_G);
            const float gl = GCb[128];
            f32x4 eq4[4], ed4[4]; v2u uc[4];
#pragma unroll
            for (int a = 0; a < 4; ++a) { eq4[a] = *(const LAS f32x4*)(GCb + 16 * a + 4 * g); ed4[a] = *(const LAS f32x4*)(GCb + 64 + 16 * a + 4 * g); uc[a] = *(const LAS v2u*)(b_ + SL_U + (16 * wave + c) * SUB + (32 * (a >> 1) + 8 * g + 4 * (a & 1)) * 2); }
            SCHED_FENCE();
            MMWQ(3, Aw1, Aq1); SCHED_FENCE();
            LDKN(0, Ak); SCHED_FENCE();
            f32x4 vn[4], vd[4];
#pragma unroll
            for (int a = 0; a < 4; ++a) { const f32x4 uu = unpack4(uc[a]);
#pragma unroll
                for (int r = 0; r < 4; ++r) { vn[a][r] = uu[r] - vw[a][r]; vd[a][r] = vn[a][r] * ed4[a][r]; qs[a][r] *= eq4[a][r]; } }
            bf16x8 Vb[2], Vd[2];
#pragma unroll
            for (int ks = 0; ks < 2; ++ks) { Vb[ks] = pack_pair(vn[2 * ks], vn[2 * ks + 1]); Vd[ks] = pack_pair(vd[2 * ks], vd[2 * ks + 1]); }
            SCHED_FENCE();
            MMKN(0, Ak); SCHED_FENCE();
            LDKN(4, Ak); SCHED_FENCE();
#pragma unroll
            for (int a = 0; a < 4; ++a) {
#pragma unroll
                for (int ks = 0; ks < 2; ++ks) qs[a] = MFMA16(Aa[a][ks], Vb[ks], qs[a]);
            }
            SCHED_FENCE();
            MMKN(4, Ak); SCHED_FENCE();
#pragma unroll
            for (int s = 0; s < 2; ++s) { const v2u lo = pack4(qs[2 * s]), hi = pack4(qs[2 * s + 1]); *(GAS v4u*)(UTg + u * CHT + (e0 + c) * 64 + 32 * s + 8 * g) = (v4u){lo.x, lo.y, hi.x, hi.y}; }
            LDS_BAR();
        }
#undef LDWQ
#undef MMWQ
#undef LDKN
#undef MMKN
    }
#undef UNIT_OF
}

__device__ __forceinline__ void combine_fast(const Str st, const float* dn_norm, LAS unsigned char* lds, int blk, int G) {
    PHASE_IDX();
    const DeltaBufs B = delta_bufs(st); const bf16* pdn = SPTR(st, bf16, OFF_PDN); bf16* mix = SPTR(st, bf16, OFF_MIX); const int nunit = (st.R / 64) * NHEAD;
    LAS unsigned char* T = lds + wave * 16384;
    LAS float* RS = (LAS float*)(lds + EXTRA_OFF + wave * 256);
    const int ck = lane & 15;
    float gn[8];
#pragma unroll
    for (int i = 0; i < 8; ++i) gn[i] = dn_norm[ck * 8 + i];
    for (int u = gw; u < nunit; u += NGW) {
        const int gch = u >> 3, head = u & 7;
        const bf16* f = B.UT0 + (size_t)u * CHT; const bf16* b = B.UT1 + (size_t)u * CHT;
        float ssa[8];
#pragma unroll
        for (int i = 0; i < 8; ++i) ssa[i] = 0.f;
        const int t8 = (lane & 7) * 8;
#pragma unroll 4
        for (int it = 0; it < 16; ++it) {
            const int e = it * 8 + (lane >> 3);
            float of[8], ob[8]; unpack8(*(const GAS v4u*)(f + e * 64 + t8), of); unpack8(*(const GAS v4u*)(b + e * 64 + t8), ob);
#pragma unroll
            for (int i = 0; i < 8; ++i) { const float o = of[i] + ob[i]; ssa[i] += o * o; const int tok = (t8 & 32) + 16 * (i >> 2) + ((t8 >> 1) & 12) + (i & 3);
                *(LAS unsigned short*)(T + tok * 256 + ((it ^ (tok & 15)) << 4) + (lane >> 3) * 2) = (unsigned short)(cvt2(o, 0.f) & 0xffffu); }
        }
#pragma unroll
        for (int i = 0; i < 8; ++i) { ssa[i] += __shfl_xor(ssa[i], 8); ssa[i] += __shfl_xor(ssa[i], 16); ssa[i] += __shfl_xor(ssa[i], 32); }
        if (lane < 8) {
#pragma unroll
            for (int i = 0; i < 8; ++i) RS[(t8 & 32) + 16 * (i >> 2) + ((t8 >> 1) & 12) + (i & 3)] = rsqrtf(ssa[i] * (1.f / 128.f) + NORM_EPS); }
        LDS_WAIT();
        v4u zq[4];
#pragma unroll
        for (int rr = 0; rr < 16; ++rr) {
            const int tok = 4 * rr + (lane >> 4); const size_t row = (size_t)gch * 64 + tok;
            if ((rr & 3) == 0) {
#pragma unroll
                for (int q4 = 0; q4 < 4; ++q4) zq[q4] = *(const GAS v4u*)(pdn + ((size_t)gch * 64 + 4 * (rr + q4) + (lane >> 4)) * NDN + 3072 + head * 128 + ck * 8); }
            float o[8], z[8]; unpack8(*(const LAS v4u*)(T + tok * 256 + ((ck ^ (tok & 15)) << 4)), o);
            unpack8(zq[rr & 3], z);
            const float rstd = RS[tok];
            float y[8];
#pragma unroll
            for (int i = 0; i < 8; ++i) y[i] = o[i] * rstd * gn[i] * siluf(z[i]);
            v4u w; w.x = cvt2(y[0], y[1]); w.y = cvt2(y[2], y[3]); w.z = cvt2(y[4], y[5]); w.w = cvt2(y[6], y[7]);
            *(GAS v4u*)(mix + row * DM + head * 128 + ck * 8) = w;
        }
        LDS_WAIT();
    }
}

struct Args { const float* in[17]; float* out; unsigned char* ws; };
__device__ __forceinline__ void norm0_phase(const Str st, const float* g, int blk, int G) {
    PHASE_IDX();
    bf16* H = SPTR(st, bf16, OFF_H);
    f32x4 gg[8];
#pragma unroll
    for (int j = 0; j < 8; ++j) gg[j] = *(const GAS f32x4*)(g + 4 * lane + 256 * j);
    for (int m = gw; m < st.R; m += NGW) norm_row(st.xin + (size_t)m * DM, gg, H + (size_t)m * DM, lane);
}
template <int MODE>
__device__ __forceinline__ void normres_phase(const Str st, size_t src_off, const float* gpost, float* out, const float* gnext, int blk, int G) {
    PHASE_IDX();
    const bf16* src = SPTR(st, bf16, src_off); bf16* H = SPTR(st, bf16, OFF_H); float* xout = out + (size_t)st.row0 * DM;
    f32x4 gp[8], gx[8];
#pragma unroll
    for (int j = 0; j < 8; ++j) { const int e = 8 * lane + 512 * (j >> 1) + 4 * (j & 1); gp[j] = *(const GAS f32x4*)(gpost + e); gx[j] = MODE != 2 ? *(const GAS f32x4*)(gnext + e) : (f32x4){0.f, 0.f, 0.f, 0.f}; }
    for (int m = gw; m < st.R; m += NGW) {
        float* slot = xout + (size_t)m * DM;
        if constexpr (MODE == 1) norm_res_row<true, false>(src + (size_t)m * DM, gp, st.xin + (size_t)m * DM, slot, MODE != 2, gx, H + (size_t)m * DM, lane);
        else if constexpr (MODE == 2) norm_res_row<false, true>(src + (size_t)m * DM, gp, slot, slot, MODE != 2, gx, H + (size_t)m * DM, lane);
        else norm_res_row<false, false>(src + (size_t)m * DM, gp, slot, slot, MODE != 2, gx, H + (size_t)m * DM, lane);
    }
}
__global__ void __launch_bounds__(NWAVES * 64, 2) enc_fwd(Args args) {
    extern __shared__ __attribute__((aligned(16))) unsigned char lds_raw[];
    LAS unsigned char* lds = (LAS unsigned char*)lds_raw;
    volatile LAS unsigned* MISC = (volatile LAS unsigned*)(lds + MISC_OFF);
    const int G = gridDim.x, blk = blockIdx.x;
    unsigned char* ws = args.ws;
    gu32* ctl = (gu32*)(ws + WS_CTL);
    for (int u = threadIdx.x; u < (LDS_BYTES - LDSCTL_OFF) / 4; u += NWAVES * 64) ((LAS unsigned*)(lds + LDSCTL_OFF))[u] = 0u;
    __syncthreads();
    XcdBarrier bar = xcd_barrier_post((unsigned*)(ctl + CW_BAR), MISC + 8);
#define GRID_BAR() xcd_barrier(bar)
#define WSP(T, off) ((T*)(ws + (off)))
    const Str SP{0, TP, ws + WS_ARENA_P, args.in[0]}, SS{TP, TSM, ws + WS_ARENA_S, args.in[1]};

#define PHASE_IN_R(st, L0_, L1_, Gs_, cs_)    do { pg8::Gemm g{SPTR(st, bf16, OFF_H), WSP(bf16, WS_WIN), (st).R, NIN, DM}; pg8::RangeOrder S; S.init((st).R, NIN, G, blk); S.L0 = (L0_); S.L1 = (L1_); S.Gs = (Gs_); S.cs = (cs_); \
          pg8::EpiBf16R E{SPTR(st, bf16, OFF_PDN), NDN, NDN / 256, SPTR(st, bf16, OFF_PSC), NSC}; \
          pg8::gemm_phase<pg8::EpiBf16R, pg8::RangeOrder, PG8_ALIGN, PG8_SP2>(lds + RING_OFF, g, S, E); } while (0)
#define PHASE_IN(st)    PHASE_IN_R(st, 0, ((st).R / 256) * (NIN / 256), G, blk)
#define PHASE_OUT(st)   do { pg8::Gemm g{SPTR(st, bf16, OFF_MIX), WSP(bf16, WS_WOUT), (st).R, DM, DM}; pg8::StaticOrder S; S.init((st).R, DM, G, blk); \
          pg8::EpiBf16R E{SPTR(st, bf16, OFF_M), DM, 1 << 20, SPTR(st, bf16, OFF_M), DM}; \
          pg8::gemm_phase<pg8::EpiBf16R, pg8::StaticOrder, PG8_ALIGN, PG8_SP2>(lds + RING_OFF, g, S, E); } while (0)
#define PHASE_UP(st, l, L0_, L1_, Gs_, cs_)   do { pg8::Gemm g{SPTR(st, bf16, OFF_H), WSP(bf16, WS_WUP), (st).R, NUP, DM}; pg8::RangeOrder S; S.init((st).R, NUP, G, blk); S.L0 = (L0_); S.L1 = (L1_); S.Gs = (Gs_); S.cs = (cs_); \
          pg8::EpiGlu E{SPTR(st, bf16, OFF_HMID), args.in[14] + (size_t)(l) * 3 * DFF, SPTR(st, float, OFF_SA), SPTR(st, float, OFF_SB), (LAS float*)(lds + EXTRA_OFF), DFF}; \
          pg8::gemm_phase<pg8::EpiGlu, pg8::RangeOrder, true, PG8_SP2>(lds + RING_OFF, g, S, E); } while (0)
#define PHASE_DOWN(st, L0_, L1_, Gs_, cs_)    do { pg8::Gemm g{SPTR(st, bf16, OFF_HMID), WSP(bf16, WS_WDN), (st).R, DM, DFF}; pg8::RangeOrder S; S.init((st).R, DM, G, blk); S.L0 = (L0_); S.L1 = (L1_); S.Gs = (Gs_); S.cs = (cs_); \
          pg8::EpiBf16R E{SPTR(st, bf16, OFF_F), DM, 1 << 20, SPTR(st, bf16, OFF_F), DM}; \
          pg8::gemm_phase<pg8::EpiBf16R, pg8::RangeOrder, PG8_ALIGN, PG8_SP2>(lds + RING_OFF, g, S, E); } while (0)
#define PHASE_SC(st, l)    sc_phase(st, args.in[8] + (size_t)(l) * 3 * 1024, args.in[9] + (size_t)(l) * 1024, blk, G)
#define PHASE_PREP(st, l)  delta_prep(st, args.in[4] + (size_t)(l) * 3 * NQKV, args.in[5] + (l) * 16, args.in[6] + (l) * 16, lds, blk, G)
#define PHASE_COMB(st, l)  combine_fast(st, args.in[7] + (l) * 128, lds, blk, G)
#define PHASE_NB(st, l)    do { if ((l) == 0) normres_phase<1>(st, OFF_M, args.in[11] + (size_t)(l) * DM, args.out, args.in[12] + (size_t)(l) * DM, blk, G); \
                                else normres_phase<0>(st, OFF_M, args.in[11] + (size_t)(l) * DM, args.out, args.in[12] + (size_t)(l) * DM, blk, G); } while (0)
#define PHASE_NC(st, l)    do { if ((l) + 1 < DEPTH) normres_phase<0>(st, OFF_F, args.in[16] + (size_t)(l) * DM, args.out, args.in[2] + (size_t)((l) + 1) * DM, blk, G); \
                                else normres_phase<2>(st, OFF_F, args.in[16] + (size_t)(l) * DM, args.out, nullptr, blk, G); } while (0)
#define PHASE_FIX(st, l)   glu_fixup_phase(st, args.in[14] + (size_t)(l) * 3 * DFF, blk, G)
#define CONVERT(l, which)  convert_weights(args.in[3] + (size_t)(l) * DM * INCOLS, args.in[10] + (size_t)(l) * DM * DM, args.in[13] + (size_t)(l) * DM * NUP, args.in[15] + (size_t)(l) * DFF * DM, which, ws, lds, blk, G)
    constexpr int UP_P = (TP / 256) * (NUP / 256), UP_P_HEAD = 192 * 14;
    constexpr int IN_S = (TSM / 256) * (NIN / 256), IN_S_HEAD = 192 * 17;
    constexpr int DN_S = (TSM / 256) * (DM / 256), DN_S_HEAD = 192 * 5;
    static_assert(DN_S - DN_S_HEAD == 64 && IN_S - IN_S_HEAD == 64 * 7, "unit split");

    CONVERT(0, 3);
    norm0_phase(SP, args.in[2], blk, G); norm0_phase(SS, args.in[2], blk, G);
    GRID_BAR();
    PHASE_IN(SP); GRID_BAR();
    PHASE_SC(SP, 0); GRID_BAR();
    PHASE_PREP(SP, 0); GRID_BAR();
    if (blk < 64) { delta_scan(SP, lds, blk, G); sub_barrier(bar, 64u); combine_fast(SP, args.in[7], lds, blk, 64); __syncthreads(); PHASE_IN_R(SS, IN_S_HEAD, IN_S, 64, blk); }
    else          { PHASE_IN_R(SS, 0, IN_S_HEAD, 192, blk - 64); }
    GRID_BAR();
    PHASE_OUT(SP); GRID_BAR();

    for (int l = 0; l < DEPTH; ++l) {
        PHASE_NB(SP, l); PHASE_SC(SS, l);
        GRID_BAR();
        PHASE_PREP(SS, l);
        GRID_BAR();
        if (blk < 64) { delta_scan(SS, lds, blk, G); PHASE_UP(SP, l, UP_P_HEAD, UP_P, 64, blk); }
        else          { PHASE_UP(SP, l, 0, UP_P_HEAD, 192, blk - 64); }
        GRID_BAR();
        PHASE_COMB(SS, l); PHASE_FIX(SP, l);
        GRID_BAR();
        PHASE_OUT(SS); PHASE_DOWN(SP, 0, (TP / 256) * (DM / 256), G, blk);
        GRID_BAR();
        PHASE_NB(SS, l); PHASE_NC(SP, l);
        if (l + 1 < DEPTH) CONVERT(l + 1, 1);
        GRID_BAR();
        if (l + 1 < DEPTH) {
            PHASE_IN(SP); PHASE_UP(SS, l, 0, (TSM / 256) * (NUP / 256), G, blk);
            GRID_BAR();
            PHASE_SC(SP, l + 1); PHASE_FIX(SS, l);
            GRID_BAR();
            PHASE_PREP(SP, l + 1);
            GRID_BAR();
            if (blk < 64) { delta_scan(SP, lds, blk, G); sub_barrier(bar, 64u * (unsigned)(l + 2)); combine_fast(SP, args.in[7] + (l + 1) * 128, lds, blk, 64); __syncthreads();
                            PHASE_DOWN(SS, DN_S_HEAD, DN_S, 64, blk); }
            else          { PHASE_DOWN(SS, 0, DN_S_HEAD, 192, blk - 64); }
            GRID_BAR();
            PHASE_NC(SS, l);
            CONVERT(l + 1, 2);
            GRID_BAR();
            PHASE_OUT(SP); PHASE_IN(SS);
            GRID_BAR();
        } else {
            PHASE_UP(SS, l, 0, (TSM / 256) * (NUP / 256), G, blk);
            GRID_BAR();
            PHASE_FIX(SS, l);
            GRID_BAR();
            PHASE_DOWN(SS, 0, DN_S, G, blk);
            GRID_BAR();
            PHASE_NC(SS, l);
        }
    }
    if (__hip_atomic_load((gu32*)(ctl + CW_BAR + XB_TMO), RLX_AGENT) != 0u) {
        const float q = __builtin_nanf(""); int tz = threadIdx.x; asm volatile("" : "+v"(tz));
        for (size_t i = (size_t)blk * (NWAVES * 64) + tz; i < (size_t)TT * DM; i += (size_t)G * NWAVES * 64) args.out[i] = q;
    }
}

extern "C" void kernel_launch(void* const* d_in, const int* in_sizes, int n_in, void* d_out, int out_size, void* d_ws, size_t ws_size, hipStream_t stream) {
    static int grid = 0;
    if (grid == 0) {
        if (n_in != 17 || out_size != TT * DM || ws_size < WS_END) { fprintf(stderr, "kernel_launch: unexpected shapes (n_in %d out %d ws %zu)\n", n_in, out_size, ws_size); grid = -1; return; }
        int dev = 0, cus = 0, per_cu = 0;
        if (hipGetDevice(&dev) != hipSuccess || hipDeviceGetAttribute(&cus, hipDeviceAttributeMultiprocessorCount, dev) != hipSuccess) { grid = -1; return; }
        if (hipFuncSetAttribute((const void*)enc_fwd, hipFuncAttributeMaxDynamicSharedMemorySize, LDS_BYTES) != hipSuccess) { fprintf(stderr, "kernel_launch: hipFuncSetAttribute failed\n"); grid = -1; return; }
        if (hipOccupancyMaxActiveBlocksPerMultiprocessor(&per_cu, (const void*)enc_fwd, NWAVES * 64, LDS_BYTES) != hipSuccess || per_cu < 1) { fprintf(stderr, "kernel_launch: occupancy query says %d\n", per_cu); grid = -1; (void)hipGetLastError(); return; }
        grid = cus;
    }
    if (grid < 0) return;
    if (hipMemsetAsync((char*)d_ws + WS_CTL, 0, CTL_ZERO_BYTES, stream) != hipSuccess) return;
    Args a{};
    for (int i = 0; i < 17; ++i) a.in[i] = (const float*)d_in[i];
    a.out = (float*)d_out; a.ws = (unsigned char*)d_ws;
    hipLaunchKernelGGL(enc_fwd, dim3(grid), dim3(NWAVES * 64), LDS_BYTES, stream, a);
}
```

```cpp
#include <hip/hip_runtime.h>
#include <cstdio>
#include <cstdint>
namespace pg8 {
#define PG8_LAS __attribute__((address_space(3)))
typedef unsigned short bf16_t;
typedef short bf16x8 __attribute__((ext_vector_type(8)));
typedef float f32x4 __attribute__((ext_vector_type(4)));
typedef unsigned u32x4 __attribute__((ext_vector_type(4)));
constexpr int BM = 256, BK = 64, HALF = 128, HTB = HALF * BK * 2  , STAGE_BYTES = 8 * HTB, NXCD = 8, WGM = 2;

__host__ __device__ __forceinline__ int lds_byte(int r, int c) { const int st = (r >> 4) * 2 + (c >> 5), rr = r & 15, cc = c & 31, ob = rr * 64 + cc * 2; return st * 1024 + (ob ^ (((ob >> 9) & 1) << 5)); }
__host__ __device__ __forceinline__ void stage_rc(int b, int& R, int& C) { const int st = b / 1024, sb = b % 1024, swz = sb ^ (((sb >> 9) & 1) << 5); R = (st >> 1) * 16 + swz / 64; C = (st & 1) * 32 + (swz % 64) / 2; }
__host__ __device__ __forceinline__ int perm32(int rho) { const int n = rho >> 4, i = rho & 15; return 8 * (i >> 2) + 4 * n + (i & 3); }

struct Unit { int pm, pn; };
struct Gemm { const bf16_t* A; const bf16_t* Bt; int M, N, K; };

struct StaticOrder {
    int nM, nN, nwg, G, c;
    __host__ __device__ void init(int M, int N, int G_, int c_) { nM = M / BM; nN = N / BM; nwg = nM * nN; G = G_; c = c_; }
    __host__ __device__ bool next(int i, Unit& u) const {
        const long L = (long)i * G + c; if (L >= nwg) return false;
        int wgid = (int)L; { const int q = nwg / NXCD, r = nwg % NXCD, xcd = wgid % NXCD, off = wgid / NXCD; wgid = (xcd < r ? xcd * (q + 1) : r * (q + 1) + (xcd - r) * q) + off; }
        const int nig = WGM * nN, gid = wgid / nig, fm = gid * WGM, gsz = (nM - fm) < WGM ? (nM - fm) : WGM;
        u.pm = fm + ((wgid % nig) % gsz); u.pn = (wgid % nig) / gsz; return true;
    }
    __device__ __forceinline__ void a_ready(const Unit&) const {}
    __device__ __forceinline__ void done(const Unit&) const {}
};
__device__ __forceinline__ unsigned cvt_pk_bf16(float lo, float hi) { unsigned r; asm volatile("v_cvt_pk_bf16_f32 %0, %1, %2" : "=v"(r) : "v"(lo), "v"(hi)); return r; }
typedef float f32x2 __attribute__((ext_vector_type(2)));
struct RangeOrder : StaticOrder {
    int L0, L1, Gs, cs;
    __device__ bool next(int i, Unit& u) const {
        const long L = (long)L0 + (long)i * Gs + cs; if (cs < 0 || L >= L1) return false;
        int wgid = (int)L; { const int q = nwg / NXCD, r = nwg % NXCD, xcd = wgid % NXCD, off = wgid / NXCD; wgid = (xcd < r ? xcd * (q + 1) : r * (q + 1) + (xcd - r) * q) + off; }
        const int nig = WGM * nN, gid = wgid / nig, fm = gid * WGM, gsz = (nM - fm) < WGM ? (nM - fm) : WGM;
        u.pm = fm + ((wgid % nig) % gsz); u.pn = (wgid % nig) / gsz; return true;
    }
};
struct EpiBf16R {
    static constexpr bool PERM = true, AFTER_DRAIN = false;
    bf16_t* O0; int ld0; int npn0; bf16_t* O1; int ld1;
    __device__ __forceinline__ void operator()(const f32x4 (&acc)[2][2][4][2], const Unit& u, int wr, int wc, int fr, int fq) const {
        const int lane = 16 * fq + fr, sr = lane >> 2, sq = lane & 3;
        const int src = (16 * sq + sr) << 2;
        const int row0 = u.pm * BM + wr * 64 + sr;
        bf16_t* base; int ldc, colt;
        if (u.pn < npn0) { base = O0; ldc = ld0; colt = u.pn * BM; } else { base = O1; ldc = ld1; colt = (u.pn - npn0) * BM; }
        const int col0 = colt + wc * 32 + 8 * sq;
#pragma unroll
        for (int ai = 0; ai < 2; ++ai)
#pragma unroll
            for (int m = 0; m < 4; ++m) { bf16_t* rowp = base + (size_t)(row0 + ai * HALF + m * 16) * ldc + col0;
#pragma unroll
                for (int bj = 0; bj < 2; ++bj) { const f32x4 v0 = acc[ai][bj][m][0], v1 = acc[ai][bj][m][1];
                    u32x4 w; w.x = cvt_pk_bf16(v0[0], v0[1]); w.y = cvt_pk_bf16(v0[2], v0[3]); w.z = cvt_pk_bf16(v1[0], v1[1]); w.w = cvt_pk_bf16(v1[2], v1[3]);
                    u32x4 t; t.x = (unsigned)__builtin_amdgcn_ds_bpermute(src, (int)w.x); t.y = (unsigned)__builtin_amdgcn_ds_bpermute(src, (int)w.y);
                    t.z = (unsigned)__builtin_amdgcn_ds_bpermute(src, (int)w.z); t.w = (unsigned)__builtin_amdgcn_ds_bpermute(src, (int)w.w);
                    *(u32x4*)(rowp + bj * HALF) = t; } }
    }
};
struct EpiGlu {
    static constexpr bool PERM = true, AFTER_DRAIN = false;
    bf16_t* HM; const float* cw; float* SA; float* SB; PG8_LAS float* XL; int dff;
    __device__ __forceinline__ void operator()(const f32x4 (&acc)[2][2][4][2], const Unit& u, int wr, int wc, int fr, int fq) const {
        const int chl = 32 * wc + 8 * fq, ch0 = 128 * u.pn + chl;
        f32x4 w0[2], w1[2], w2[2];
#pragma unroll
        for (int n = 0; n < 2; ++n) { w0[n] = *(const f32x4*)(cw + ch0 + 4 * n); w1[n] = *(const f32x4*)(cw + dff + ch0 + 4 * n); w2[n] = *(const f32x4*)(cw + 2 * dff + ch0 + 4 * n); }
#pragma unroll
        for (int ai = 0; ai < 2; ++ai) { const int bi = 2 * ai + wr;
            if (fr == 0) {
#pragma unroll
                for (int n = 0; n < 2; ++n) *(PG8_LAS f32x4*)(XL + bi * 128 + chl + 4 * n) = acc[ai][0][0][n]; }
            if (fr == 15) {
#pragma unroll
                for (int n = 0; n < 2; ++n) *(PG8_LAS f32x4*)(XL + 512 + bi * 128 + chl + 4 * n) = acc[ai][0][3][n]; }
        }
        if (wr == 0 && fr < 2) {
#pragma unroll
            for (int n = 0; n < 2; ++n) { *(f32x4*)(SA + ((size_t)u.pm * 4 + fr) * dff + ch0 + 4 * n) = acc[0][0][0][n]; if (fr == 0) *(f32x4*)(SB + ((size_t)u.pm * 2) * dff + ch0 + 4 * n) = acc[0][1][0][n]; } }
        if (wr == 1 && fr >= 14) {
#pragma unroll
            for (int n = 0; n < 2; ++n) { *(f32x4*)(SA + ((size_t)u.pm * 4 + fr - 12) * dff + ch0 + 4 * n) = acc[1][0][3][n]; if (fr == 15) *(f32x4*)(SB + ((size_t)u.pm * 2 + 1) * dff + ch0 + 4 * n) = acc[1][1][3][n]; } }
        asm volatile("s_waitcnt lgkmcnt(0)\n\ts_barrier" ::: "memory");
        f32x4 w0m[2], w2m[2];
#pragma unroll
        for (int n = 0; n < 2; ++n)
#pragma unroll
            for (int j = 0; j < 4; ++j) { w0m[n][j] = fr == 0 ? w0[n][j] : 0.f; w2m[n][j] = fr == 15 ? w2[n][j] : 0.f; }
#pragma unroll
        for (int ai = 0; ai < 2; ++ai) { const int bi = 2 * ai + wr;
            unsigned ow[4][4];
#pragma unroll
            for (int n = 0; n < 2; ++n) {
                const f32x4 pblk = bi > 0 ? *(const PG8_LAS f32x4*)(XL + 512 + (bi - 1) * 128 + chl + 4 * n) : (f32x4){0.f, 0.f, 0.f, 0.f};
                const f32x4 nblk = bi < 3 ? *(const PG8_LAS f32x4*)(XL + (bi + 1) * 128 + chl + 4 * n) : (f32x4){0.f, 0.f, 0.f, 0.f};
#pragma unroll
                for (int m = 0; m < 4; ++m) { float o[4]; f32x2 sv[2];
#pragma unroll
                    for (int jp = 0; jp < 4; jp += 2) {
                        const float c0 = acc[ai][0][m][n][jp], c1 = acc[ai][0][m][n][jp + 1];
                        const float p0 = m > 0 ? acc[ai][0][m > 0 ? m - 1 : 0][n][jp] : pblk[jp], p1 = m > 0 ? acc[ai][0][m > 0 ? m - 1 : 0][n][jp + 1] : pblk[jp + 1];
                        const float n0 = m < 3 ? acc[ai][0][m < 3 ? m + 1 : 3][n][jp] : nblk[jp], n1 = m < 3 ? acc[ai][0][m < 3 ? m + 1 : 3][n][jp + 1] : nblk[jp + 1];
                        float s0, s1;
                        asm("v_mul_f32 %0, %8, %2\n\tv_mul_f32 %1, %9, %3\n\t"
                            "v_fmac_f32_dpp %0, %2, %10 row_shr:1 row_mask:0xf bank_mask:0xf bound_ctrl:1\n\t"
                            "v_fmac_f32_dpp %1, %3, %11 row_shr:1 row_mask:0xf bank_mask:0xf bound_ctrl:1\n\t"
                            "v_fmac_f32_dpp %0, %2, %12 row_shl:1 row_mask:0xf bank_mask:0xf bound_ctrl:1\n\t"
                            "v_fmac_f32_dpp %1, %3, %13 row_shl:1 row_mask:0xf bank_mask:0xf bound_ctrl:1\n\t"
                            "v_fmac_f32_dpp %0, %4, %14 row_ror:1 row_mask:0xf bank_mask:0xf bound_ctrl:1\n\t"
                            "v_fmac_f32_dpp %1, %5, %15 row_ror:1 row_mask:0xf bank_mask:0xf bound_ctrl:1\n\t"
                            "v_fmac_f32_dpp %0, %6, %16 row_ror:15 row_mask:0xf bank_mask:0xf bound_ctrl:1\n\t"
                            "v_fmac_f32_dpp %1, %7, %17 row_ror:15 row_mask:0xf bank_mask:0xf bound_ctrl:1"
                            : "=&v"(s0), "=&v"(s1)
                            : "v"(c0), "v"(c1), "v"(p0), "v"(p1), "v"(n0), "v"(n1), "v"(w1[n][jp]), "v"(w1[n][jp + 1]), "v"(w0[n][jp]), "v"(w0[n][jp + 1]),
                              "v"(w2[n][jp]), "v"(w2[n][jp + 1]), "v"(w0m[n][jp]), "v"(w0m[n][jp + 1]), "v"(w2m[n][jp]), "v"(w2m[n][jp + 1]));
                        sv[jp >> 1] = (f32x2){s0, s1}; }
                    const f32x2 ta = sv[0] * -1.4426950408889634f, tb = sv[1] * -1.4426950408889634f;
                    const f32x2 da = (f32x2){__builtin_amdgcn_exp2f(ta.x), __builtin_amdgcn_exp2f(ta.y)} + 1.f, db = (f32x2){__builtin_amdgcn_exp2f(tb.x), __builtin_amdgcn_exp2f(tb.y)} + 1.f;
                    const f32x2 va = {acc[ai][1][m][n][0], acc[ai][1][m][n][1]}, vb = {acc[ai][1][m][n][2], acc[ai][1][m][n][3]};
                    const f32x2 pa = sv[0] * va, pb2 = sv[1] * vb;
                    const f32x2 oa = pa * (f32x2){__builtin_amdgcn_rcpf(da.x), __builtin_amdgcn_rcpf(da.y)}, ob = pb2 * (f32x2){__builtin_amdgcn_rcpf(db.x), __builtin_amdgcn_rcpf(db.y)};
                    o[0] = oa.x; o[1] = oa.y; o[2] = ob.x; o[3] = ob.y;
                    ow[m][2 * n] = cvt_pk_bf16(o[0], o[1]); ow[m][2 * n + 1] = cvt_pk_bf16(o[2], o[3]); }
            }
#pragma unroll
            for (int m = 0; m < 4; ++m) { u32x4 w; w.x = ow[m][0]; w.y = ow[m][1]; w.z = ow[m][2]; w.w = ow[m][3];
                *(u32x4*)(HM + (size_t)(u.pm * BM + 128 * ai + 64 * wr + 16 * m + fr) * dff + ch0) = w; }
        }
    }
};
template <class Epi, class Sched, bool ALIGN_EPI = false, bool SP2 = false>
__device__ __forceinline__ void gemm_phase(PG8_LAS unsigned char* lds, const Gemm g, const Sched& S, const Epi& E) {
    int tid_o = threadIdx.x; asm volatile("" : "+v"(tid_o)); const int tid = tid_o, wid = __builtin_amdgcn_readfirstlane(tid >> 6), lane = tid & 63, wr = wid >> 2, wc = wid & 3, fr = lane & 15, fq = lane >> 4;
    const int K = g.K, nt = K / BK;
    unsigned voffA[2], voffB[2];
#pragma unroll
    for (int i = 0; i < 2; ++i) { int R, C; stage_rc(tid * 16 + i * 8192, R, C); const int Rb = Epi::PERM ? ((R & ~31) + perm32(R & 31)) : R;
        voffA[i] = (unsigned)(R * K + C) * 2u; voffB[i] = (unsigned)(Rb * K + C) * 2u; }
    const size_t kstep = (size_t)(BK * 2);
    const size_t hstep = (size_t)HALF * K * 2;
    const size_t tstep = 2 * hstep;
    const unsigned ldsw = (unsigned)wid * 1024u;
    const int aoff = lds_byte(wr * 64 + fr, fq * 8), boff = lds_byte(wc * 32 + fr, fq * 8);
#define PG8_SA(b, h) (((b) * 2 + (h)) * HTB)
#define PG8_SB(b, h) ((4 + (b) * 2 + (h)) * HTB)
#define PG8_STAGE(bufoff, gbase, voff) do { _Pragma("unroll") for (int _i = 0; _i < 2; ++_i) \
        __builtin_amdgcn_global_load_lds((const unsigned*)((const char*)(gbase) + (voff)[_i]), (PG8_LAS unsigned*)(lds + (bufoff) + ldsw + _i * 8192), 16, 0, 0); } while (0)
#define PG8_LDA(dst, b, h) do { _Pragma("unroll") for (int m = 0; m < 4; ++m) _Pragma("unroll") for (int k = 0; k < 2; ++k) dst[m][k] = *(const PG8_LAS bf16x8*)(lds + PG8_SA(b, h) + aoff + m * 2048 + k * 1024); } while (0)
#define PG8_LDB(dst, b, h) do { _Pragma("unroll") for (int n = 0; n < 2; ++n) _Pragma("unroll") for (int k = 0; k < 2; ++k) dst[n][k] = *(const PG8_LAS bf16x8*)(lds + PG8_SB(b, h) + boff + n * 2048 + k * 1024); } while (0)
#define PG8_MMA(ai, bj, At, Bt) do { __builtin_amdgcn_s_setprio(1); _Pragma("unroll") for (int m = 0; m < 4; ++m) _Pragma("unroll") for (int n = 0; n < 2; ++n) _Pragma("unroll") for (int k = 0; k < 2; ++k) \
        acc[ai][bj][m][n] = __builtin_amdgcn_mfma_f32_16x16x32_bf16(Bt[n][k], At[m][k], acc[ai][bj][m][n], 0, 0, 0); __builtin_amdgcn_s_setprio(0); } while (0)
#define PG8_WAIT_V(n) asm volatile("s_waitcnt vmcnt(" #n ")" ::: "memory")
#define PG8_WAIT_L(n) asm volatile("s_waitcnt lgkmcnt(" #n ")" ::: "memory")
#define PG8_BAR __builtin_amdgcn_s_barrier()
#define PG8_SCHED __builtin_amdgcn_sched_barrier(0)
    Unit cur, nxt; int ui = 0;
    if (!S.next(0, cur)) return;
    f32x4 acc[2][2][4][2];
#pragma unroll
    for (int a = 0; a < 2; ++a)
#pragma unroll
        for (int b = 0; b < 2; ++b)
#pragma unroll
            for (int m = 0; m < 4; ++m)
#pragma unroll
                for (int n = 0; n < 2; ++n) acc[a][b][m][n] = (f32x4){0.f, 0.f, 0.f, 0.f};
    bf16x8 At[4][2], B0[2][2], B1[2][2];
    const char* cA = (const char*)g.A + (size_t)cur.pm * tstep; const char* cB = (const char*)g.Bt + (size_t)cur.pn * tstep;
    S.a_ready(cur);
    if constexpr (SP2) {
        PG8_STAGE(PG8_SB(0, 0), cB, voffB); PG8_STAGE(PG8_SB(0, 1), cB + hstep, voffB); PG8_STAGE(PG8_SA(0, 0), cA, voffA); PG8_STAGE(PG8_SA(0, 1), cA + hstep, voffA);
        if (wr == 1) PG8_BAR;
        PG8_WAIT_V(2); PG8_BAR;
        PG8_STAGE(PG8_SB(1, 0), cB + kstep, voffB); PG8_STAGE(PG8_SA(1, 0), cA + kstep, voffA); PG8_STAGE(PG8_SB(1, 1), cB + hstep + kstep, voffB);
        PG8_WAIT_V(6); PG8_BAR;
    } else {
        PG8_STAGE(PG8_SB(0, 0), cB, voffB); PG8_STAGE(PG8_SA(0, 0), cA, voffA); PG8_STAGE(PG8_SB(0, 1), cB + hstep, voffB); PG8_STAGE(PG8_SA(0, 1), cA + hstep, voffA);
        if (wr == 1) PG8_BAR;
        PG8_WAIT_V(4); PG8_BAR;
        PG8_STAGE(PG8_SB(1, 0), cB + kstep, voffB); PG8_STAGE(PG8_SA(1, 0), cA + kstep, voffA); PG8_STAGE(PG8_SB(1, 1), cB + hstep + kstep, voffB);
        PG8_WAIT_V(6); PG8_BAR;
    }
    for (;;) {
        const bool has_next = S.next(ui + 1, nxt);
        const char* nA = has_next ? (const char*)g.A + (size_t)nxt.pm * tstep : cA; const char* nB = has_next ? (const char*)g.Bt + (size_t)nxt.pn * tstep : cB;
        for (int t = 0; t < nt; t += 2) {
            const bool last = (t == nt - 2);
            const char* a1 = cA + (size_t)(t + 1) * kstep;
            const char* a2 = last ? nA : cA + (size_t)(t + 2) * kstep; const char* b2 = last ? nB : cB + (size_t)(t + 2) * kstep;
            const char* a3 = a2 + kstep; const char* b3 = b2 + kstep;
            if (last && has_next) S.a_ready(nxt);
            if constexpr (SP2) {
            PG8_LDB(B0, 0, 0); PG8_LDB(B1, 0, 1); PG8_SCHED; PG8_LDA(At, 0, 0); PG8_STAGE(PG8_SA(1, 1), a1 + hstep, voffA);
            PG8_WAIT_V(8); PG8_WAIT_L(0); PG8_BAR; PG8_MMA(0, 0, At, B0); PG8_MMA(0, 1, At, B1); PG8_BAR; PG8_SCHED;
            PG8_LDA(At, 0, 1); PG8_STAGE(PG8_SB(0, 0), b2, voffB); PG8_STAGE(PG8_SB(0, 1), b2 + hstep, voffB); PG8_STAGE(PG8_SA(0, 0), a2, voffA);
            PG8_WAIT_V(8); PG8_WAIT_L(0); PG8_BAR; PG8_MMA(1, 0, At, B0); PG8_MMA(1, 1, At, B1); PG8_BAR; PG8_SCHED;
            PG8_LDB(B0, 1, 0); PG8_LDB(B1, 1, 1); PG8_SCHED; PG8_LDA(At, 1, 0); PG8_STAGE(PG8_SA(0, 1), a2 + hstep, voffA);
            PG8_WAIT_V(8); PG8_WAIT_L(0); PG8_BAR; PG8_MMA(0, 0, At, B0); PG8_MMA(0, 1, At, B1); PG8_BAR; PG8_SCHED;
            PG8_LDA(At, 1, 1); PG8_STAGE(PG8_SB(1, 0), b3, voffB); PG8_STAGE(PG8_SB(1, 1), b3 + hstep, voffB); PG8_STAGE(PG8_SA(1, 0), a3, voffA);
            PG8_WAIT_V(8); PG8_WAIT_L(0); PG8_BAR; PG8_MMA(1, 0, At, B0); PG8_MMA(1, 1, At, B1); PG8_BAR; PG8_SCHED;
            } else {
            PG8_LDB(B0, 0, 0); PG8_SCHED; PG8_LDA(At, 0, 0); PG8_STAGE(PG8_SA(1, 1), a1 + hstep, voffA);
            PG8_WAIT_L(8); PG8_BAR; PG8_WAIT_L(0); PG8_MMA(0, 0, At, B0); PG8_BAR; PG8_SCHED;
            PG8_LDB(B1, 0, 1); PG8_STAGE(PG8_SB(0, 0), b2, voffB);
            PG8_BAR; PG8_WAIT_L(0); PG8_MMA(0, 1, At, B1); PG8_BAR;
            PG8_LDA(At, 0, 1); PG8_STAGE(PG8_SA(0, 0), a2, voffA);
            PG8_BAR; PG8_WAIT_L(0); PG8_MMA(1, 0, At, B0); PG8_BAR; PG8_SCHED;
            PG8_STAGE(PG8_SB(0, 1), b2 + hstep, voffB);
            PG8_WAIT_V(6); PG8_BAR; PG8_MMA(1, 1, At, B1); PG8_BAR;
            PG8_LDB(B0, 1, 0); PG8_SCHED; PG8_LDA(At, 1, 0); PG8_STAGE(PG8_SA(0, 1), a2 + hstep, voffA);
            PG8_WAIT_L(8); PG8_BAR; PG8_WAIT_L(0); PG8_MMA(0, 0, At, B0); PG8_BAR; PG8_SCHED;
            PG8_LDB(B1, 1, 1); PG8_STAGE(PG8_SB(1, 0), b3, voffB);
            PG8_BAR; PG8_WAIT_L(0); PG8_MMA(0, 1, At, B1); PG8_BAR;
            PG8_LDA(At, 1, 1); PG8_STAGE(PG8_SA(1, 0), a3, voffA);
            PG8_BAR; PG8_WAIT_L(0); PG8_MMA(1, 0, At, B0); PG8_BAR; PG8_SCHED;
            PG8_STAGE(PG8_SB(1, 1), b3 + hstep, voffB);
            PG8_WAIT_V(6); PG8_BAR; PG8_MMA(1, 1, At, B1); PG8_BAR;
            }
        }
        if constexpr (ALIGN_EPI) { if (wr == 0) PG8_BAR; }
        if constexpr (!Epi::AFTER_DRAIN) { E(acc, cur, wr, wc, fr, fq); S.done(cur); }
        if (!has_next) break;
#pragma unroll
        for (int a = 0; a < 2; ++a)
#pragma unroll
            for (int b = 0; b < 2; ++b)
#pragma unroll
                for (int m = 0; m < 4; ++m)
#pragma unroll
                    for (int n = 0; n < 2; ++n) acc[a][b][m][n] = (f32x4){0.f, 0.f, 0.f, 0.f};
        cur = nxt; cA = nA; cB = nB; ++ui;
        if constexpr (ALIGN_EPI) { if (wr == 1) PG8_BAR; }
    }
    PG8_WAIT_V(0);
    if constexpr (!ALIGN_EPI) { if (wr == 0) PG8_BAR; }
    PG8_BAR;
    if constexpr (Epi::AFTER_DRAIN) { E.fused(acc, cur, wr, wc, fr, fq, lds, wid, lane); S.done(cur); }
#undef PG8_SA
#undef PG8_SB
#undef PG8_STAGE
#undef PG8_LDA
#undef PG8_LDB
#undef PG8_MMA
#undef PG8_WAIT_V
#undef PG8_WAIT_L
#undef PG8_BAR
#undef PG8_SCHED
}
}
#ifndef PG8_SP2
#define PG8_SP2 true
#endif
#ifndef PG8_ALIGN
#define PG8_ALIGN true
#endif

constexpr int NWAVES = 8;
constexpr int DM = 2048, DEPTH = 4, TP = 16384, TSM = 32768, TT = TP + TSM;
constexpr int NQKV = 3072, NDNR = 4128, NDN = 4352, NSC = 3072, NIN = NDN + NSC, INCOLS = 7200;
constexpr int DFF = 5632, NUP = 2 * DFF;
constexpr int NHEAD = 8, HD = 128, CH = 64;
constexpr int SECROWS = 16384, NSEC = 3;
constexpr float NORM_EPS = 1e-6f, L2_EPS = 1e-6f;

constexpr size_t MiB = 1u << 20;
constexpr size_t WS_CTL = 0, CTL_ZERO_BYTES = 1 * MiB;
constexpr size_t WS_WIN = 1 * MiB, WS_WOUT = 30 * MiB, WS_WUP = 38 * MiB, WS_WDN = 82 * MiB;
constexpr size_t OFF_H = 0, OFF_QN = 0, OFF_KN = 2048, OFF_MIX = 4096, OFF_PDN = 8192, OFF_M = 8192, OFF_HMID = 4096, OFF_PSC = 16896, OFF_W0 = 16896, OFF_W1 = 18944, OFF_UT0 = 20992, OFF_F = 16896;
constexpr size_t OFF_UT1 = 23040, OFF_SA = 23040, OFF_SB = 23392, OFF_AQ0 = 25088, OFF_AQ1 = 26112, OFF_GC0 = 27136, OFF_GC1 = 27232, ROW_BYTES = 27328;
constexpr size_t WS_ARENA_P = 105 * MiB, WS_ARENA_S = WS_ARENA_P + ROW_BYTES * TP, WS_END = WS_ARENA_S + ROW_BYTES * TSM;
static_assert(WS_WIN + (size_t)NIN * DM * 2 <= WS_WOUT && WS_WOUT + (size_t)DM * DM * 2 <= WS_WUP && WS_WUP + (size_t)NUP * DM * 2 <= WS_WDN && WS_WDN + (size_t)DM * DFF * 2 <= WS_ARENA_P, "weights map");
static_assert(WS_END <= 1408 * MiB && OFF_HMID + 11264 <= OFF_F && OFF_SB + 176 <= OFF_AQ0 && OFF_M + 4096 <= OFF_PSC, "arena map");
constexpr int CW_BAR = 4096;

constexpr int RING_OFF = 0, RING_BYTES = 147456;
constexpr int EXTRA_OFF = RING_BYTES, LDSCTL_OFF = RING_BYTES + 8192, MISC_OFF = LDSCTL_OFF + 320;
constexpr int LDS_BYTES = RING_BYTES + 8192 + 512;

#define GAS __attribute__((address_space(1)))
#define LAS __attribute__((address_space(3)))
typedef unsigned short bf16;
typedef unsigned v4u __attribute__((ext_vector_type(4)));
typedef unsigned v2u __attribute__((ext_vector_type(2)));
typedef float f32x4 __attribute__((ext_vector_type(4)));
typedef GAS unsigned gu32;
#define RLX_AGENT __ATOMIC_RELAXED, __HIP_MEMORY_SCOPE_AGENT
#define LDS_WAIT() asm volatile("s_waitcnt lgkmcnt(0)" ::: "memory")
#define VM_WAIT() asm volatile("s_waitcnt vmcnt(0)" ::: "memory")
#define LDS_BAR() asm volatile("s_waitcnt lgkmcnt(0)\n\ts_barrier" ::: "memory")
typedef __bf16 bf2_t __attribute__((ext_vector_type(2)));
typedef float f2_t __attribute__((ext_vector_type(2)));
__device__ __forceinline__ unsigned cvt2(float a, float b) { const f2_t v = {a, b}; return __builtin_bit_cast(unsigned, __builtin_convertvector(v, bf2_t)); }
__device__ __forceinline__ unsigned f2bf(float f) { unsigned u = __builtin_bit_cast(unsigned, f); return (u + 0x7fffu + ((u >> 16) & 1u)) >> 16; }
__device__ __forceinline__ unsigned pk2(float lo, float hi) { return cvt2(lo, hi); }
__device__ __forceinline__ float bflo(unsigned u) { return __builtin_bit_cast(float, u << 16); }
__device__ __forceinline__ float bfhi(unsigned u) { return __builtin_bit_cast(float, u & 0xffff0000u); }
__device__ __forceinline__ float bf1(bf16 b) { return __builtin_bit_cast(float, ((unsigned)b) << 16); }
__device__ __forceinline__ void unpack8(const v4u w, float (&f)[8]) { f[0] = bflo(w.x); f[1] = bfhi(w.x); f[2] = bflo(w.y); f[3] = bfhi(w.y); f[4] = bflo(w.z); f[5] = bfhi(w.z); f[6] = bflo(w.w); f[7] = bfhi(w.w); }
__device__ __forceinline__ float wave_sum(float v) {
#pragma unroll
    for (int o = 1; o < 64; o <<= 1) v += __shfl_xor(v, o);
    return v;
}
__device__ __forceinline__ float siluf(float x) { return x * __builtin_amdgcn_rcpf(1.f + __expf(-x)); }
__device__ __forceinline__ void seq_bounds(int r, int& start, int& len) {
    if (r < TP) { len = 8192; start = r & ~8191; } else { len = 16384; start = TP + ((r - TP) & ~16383); }
}
#define XB_TMO      128
#define XB_XCNT(j)  (256  + 64 * (j))
#define XB_XSUB(j)  (1280 + 64 * (j))
#define XB_XGEN(j)  (2304 + 64 * (j))
#define XB_TOP      3328
#define XB_TOPGEN   3392
#define XB_SUBW     3456
#define XCD_BAR_WORDS 3456
#define XB_SPIN_CAP (1u << 18)

__device__ __forceinline__ unsigned xb_ld(unsigned* p)              { return __hip_atomic_load(p, __ATOMIC_RELAXED, __HIP_MEMORY_SCOPE_AGENT); }
__device__ __forceinline__ unsigned xb_add(unsigned* p, unsigned v) { return __hip_atomic_fetch_add(p, v, __ATOMIC_RELAXED, __HIP_MEMORY_SCOPE_AGENT); }
__device__ __forceinline__ unsigned xb_xcc_id() { return (unsigned)__builtin_amdgcn_s_getreg((3 << 11) | 20) & 0xFu; }
#define XB_SPIN(cond, bar) do { unsigned _sp = 0; while (cond) { __builtin_amdgcn_s_sleep(1); \
    if ((++_sp & 255u) == 0u) { if (xb_ld(&(bar)[XB_TMO])) break; if (_sp > XB_SPIN_CAP) { atomicAdd(&(bar)[XB_TMO], 1u); break; } } } } while (0)

struct XcdBarrier {
    unsigned* bar; unsigned x;
    volatile LAS unsigned* st;
};

__device__ __forceinline__ XcdBarrier xcd_barrier_post(unsigned* bar, volatile LAS unsigned* st) {
    XcdBarrier b; b.bar = bar; b.x = xb_xcc_id(); b.st = st;
    if (threadIdx.x == 0) (void)xb_add(&bar[XB_XCNT(b.x)], 1u);
    return b;
}
__device__ __forceinline__ void xcd_barrier_complete(unsigned* bar, unsigned x, unsigned& nloc, unsigned& nx) {
    const unsigned G = gridDim.x * gridDim.y * gridDim.z;
    unsigned sum, cnt, mine, sp = 0u;
    for (;;) {
        sum = 0u; cnt = 0u; mine = 0u;
#pragma unroll
        for (unsigned j = 0; j < 16; ++j) { const unsigned c = xb_ld(&bar[XB_XCNT(j)]); sum += c; cnt += (c > 0u) ? 1u : 0u; mine = (j == x) ? c : mine; }
        if (sum == G) break;
        __builtin_amdgcn_s_sleep(1);
        if ((++sp & 255u) == 0u) { if (xb_ld(&bar[XB_TMO])) break; if (sp > XB_SPIN_CAP) { atomicAdd(&bar[XB_TMO], 1u); break; } }
    }
    nloc = mine > 0u ? mine : 1u; nx = cnt > 0u ? cnt : 1u;
}

__device__ __forceinline__ void xcd_barrier(const XcdBarrier& b) {
    asm volatile("s_waitcnt vmcnt(0)" ::: "memory");
    __syncthreads();
    if (threadIdx.x == 0) {
        unsigned* bar = b.bar; unsigned bx = b.x;
        asm volatile("" : "+s"(bar), "+s"(bx));
        __builtin_amdgcn_s_waitcnt(0);
        unsigned nloc = b.st[0], nx = b.st[1];
        if (nloc == 0u) { xcd_barrier_complete(bar, bx, nloc, nx); b.st[0] = nloc; b.st[1] = nx; }
        const unsigned old = xb_add(&bar[XB_XSUB(bx)], 1u);
        const unsigned gen = old / nloc;
        if (old + 1u == (gen + 1u) * nloc) {
            __builtin_amdgcn_fence(__ATOMIC_RELEASE, "agent");
            asm volatile("s_waitcnt vmcnt(0)" ::: "memory");
            const unsigned og = xb_add(&bar[XB_TOP], 1u);
            const unsigned tg = og / nx;
            if (og + 1u == (tg + 1u) * nx) xb_add(&bar[XB_TOPGEN], 1u);
            else XB_SPIN(xb_ld(&bar[XB_TOPGEN]) == tg, bar);
            __builtin_amdgcn_fence(__ATOMIC_ACQUIRE, "agent");
            xb_add(&bar[XB_XGEN(bx)], 1u);
            asm volatile("s_waitcnt vmcnt(0)" ::: "memory");
        } else {
            XB_SPIN(xb_ld(&bar[XB_XGEN(bx)]) == gen, bar);
            __builtin_amdgcn_fence(__ATOMIC_ACQUIRE, "agent");
            asm volatile("s_waitcnt vmcnt(0)" ::: "memory");
        }
    }
    __syncthreads();
}
__device__ __forceinline__ void sub_barrier(const XcdBarrier& b, unsigned target) {
    asm volatile("s_waitcnt vmcnt(0)" ::: "memory");
    __syncthreads();
    if (threadIdx.x == 0) {
        unsigned* bar = b.bar; asm volatile("" : "+s"(bar));
        __builtin_amdgcn_fence(__ATOMIC_RELEASE, "agent");
        asm volatile("s_waitcnt vmcnt(0)" ::: "memory");
        (void)xb_add(&bar[XB_SUBW], 1u);
        XB_SPIN(xb_ld(&bar[XB_SUBW]) < target, bar);
        __builtin_amdgcn_fence(__ATOMIC_ACQUIRE, "agent");
        asm volatile("s_waitcnt vmcnt(0)" ::: "memory");
    }
    __syncthreads();
}
struct Str { int row0, R; unsigned char* base; const float* xin; };
#define SPTR(s, T, OFF) ((T*)((s).base + (size_t)(OFF) * (s).R))
#define PHASE_IDX() int tid_ = threadIdx.x; asm volatile("" : "+v"(tid_)); const int tid = tid_, lane = tid & 63, wave = __builtin_amdgcn_readfirstlane(tid >> 6); \
    const int gw = blk * NWAVES + wave, NGW = G * NWAVES, gtid = blk * (NWAVES * 64) + tid, NGT = G * NWAVES * 64; (void)lane; (void)gw; (void)NGW; (void)gtid; (void)NGT;
struct TrItem { const float* W; bf16* WT; int K, N, k0, n0, roff; };
__device__ __forceinline__ void tr_load(const TrItem t, f32x4 (&v)[8], int lane) {
#pragma unroll
    for (int i = 0; i < 8; ++i) v[i] = *(const GAS f32x4*)(t.W + (size_t)(t.k0 + 8 * i + (lane >> 3)) * t.N + t.n0 + (lane & 7) * 4);
}
__device__ __forceinline__ void tr_store(const TrItem t, const f32x4 (&v)[8], LAS float* scr, int lane) {
#pragma unroll
    for (int i = 0; i < 8; ++i) { const int kk = 8 * i + (lane >> 3), c4 = (lane & 7) * 4; scr[kk * 33 + c4] = v[i].x; scr[kk * 33 + c4 + 1] = v[i].y; scr[kk * 33 + c4 + 2] = v[i].z; scr[kk * 33 + c4 + 3] = v[i].w; }
    LDS_WAIT(); asm volatile("" ::: "memory");
    const int c = lane & 7;
#pragma unroll
    for (int j = 0; j < 4; ++j) { const int n = (lane >> 3) + 8 * j; const LAS float* s = scr + (8 * c) * 33 + n;
        v4u o; o.x = pk2(s[0 * 33], s[1 * 33]); o.y = pk2(s[2 * 33], s[3 * 33]); o.z = pk2(s[4 * 33], s[5 * 33]); o.w = pk2(s[6 * 33], s[7 * 33]);
        *(GAS v4u*)(t.WT + (size_t)(t.roff + t.n0 + n) * t.K + t.k0 + 8 * c) = o; }
    LDS_WAIT(); asm volatile("" ::: "memory");
}
__device__ __forceinline__ void convert_weights(const float* w_in, const float* w_out, const float* w_up, const float* w_down, int which, unsigned char* ws, LAS unsigned char* lds, int blk, int G) {
    PHASE_IDX();
    LAS float* scr = (LAS float*)(lds + RING_OFF + wave * 16384);
    bf16* WIN = (bf16*)(ws + WS_WIN); bf16* WOUT = (bf16*)(ws + WS_WOUT); bf16* WUP = (bf16*)(ws + WS_WUP); bf16* WDN = (bf16*)(ws + WS_WDN);
    constexpr int I_IN = (DM / 64) * (INCOLS / 32), I_OUT = (DM / 64) * (DM / 32), I_UP = (DM / 64) * (NUP / 32), I_DN = (DFF / 64) * (DM / 32);
    const int lo = (which & 1) ? 0 : I_IN + I_OUT, hi = (which & 2) ? I_IN + I_OUT + I_UP + I_DN : I_IN + I_OUT;
    auto item = [&](int it) -> TrItem {
        TrItem t; int r = it;
        if (r < I_IN) { t.W = w_in; t.WT = WIN; t.K = DM; t.N = INCOLS; }
        else if ((r -= I_IN) < I_OUT) { t.W = w_out; t.WT = WOUT; t.K = DM; t.N = DM; }
        else if ((r -= I_OUT) < I_UP) { t.W = w_up; t.WT = WUP; t.K = DM; t.N = NUP; }
        else { r -= I_UP; t.W = w_down; t.WT = WDN; t.K = DFF; t.N = DM; }
        const int nblk = t.N / 32; t.k0 = 64 * (r / nblk); t.n0 = 32 * (r % nblk);
        t.roff = (t.W == w_in) ? (t.n0 >= NDNR ? NDN - NDNR : 0) : (t.W == w_up) ? ((t.n0 < DFF ? (t.n0 >> 7) * 256 + (t.n0 & 127) : ((t.n0 - DFF) >> 7) * 256 + 128 + ((t.n0 - DFF) & 127)) - t.n0) : 0;
        return t; };
    int it = lo + gw;
    f32x4 v[8], vn[8];
    TrItem cur = item(it < hi ? it : lo);
    if (it < hi) tr_load(cur, v, lane);
    while (it < hi) {
        const int nit = it + NGW; TrItem nxt = cur;
        if (nit < hi) { nxt = item(nit); tr_load(nxt, vn, lane); }
        tr_store(cur, v, scr, lane);
#pragma unroll
        for (int i = 0; i < 8; ++i) v[i] = vn[i];
        cur = nxt; it = nit;
    }
    __syncthreads();
}

__device__ __forceinline__ void norm_row(const float* xrow, const f32x4 (&g)[8], bf16* hrow, int lane) {
    f32x4 v[8]; float ss = 0.f;
#pragma unroll
    for (int j = 0; j < 8; ++j) { v[j] = __builtin_nontemporal_load((const GAS f32x4*)(xrow + 4 * lane + 256 * j)); ss += (v[j].x * v[j].x + v[j].y * v[j].y) + (v[j].z * v[j].z + v[j].w * v[j].w); }
    const float rstd = rsqrtf(wave_sum(ss) * (1.f / DM) + NORM_EPS);
#pragma unroll
    for (int j = 0; j < 8; ++j) { const f32x4 gg = g[j];
        v2u o; o.x = pk2(v[j].x * rstd * gg.x, v[j].y * rstd * gg.y); o.y = pk2(v[j].z * rstd * gg.z, v[j].w * rstd * gg.w);
        *(GAS v2u*)(hrow + 4 * lane + 256 * j) = o; }
}
template <bool XIN_F32, bool XOUT_F32>
__device__ __forceinline__ void norm_res_row(const bf16* srow, const f32x4 (&gp)[8], const void* xin, void* xout, bool has_next, const f32x4 (&gx)[8], bf16* hrow, int lane) {
    f32x4 v[8], xi[8]; float ss = 0.f;
    v4u w[4], xw[4];
#pragma unroll
    for (int j = 0; j < 4; ++j) { w[j] = *(const GAS v4u*)(srow + 8 * lane + 512 * j);
        if constexpr (XIN_F32) { xi[2 * j] = __builtin_nontemporal_load((const GAS f32x4*)((const float*)xin + 8 * lane + 512 * j)); xi[2 * j + 1] = __builtin_nontemporal_load((const GAS f32x4*)((const float*)xin + 8 * lane + 512 * j + 4)); }
        else xw[j] = __builtin_nontemporal_load((const GAS v4u*)((const bf16*)xin + 8 * lane + 512 * j)); }
#pragma unroll
    for (int j = 0; j < 4; ++j) { v[2 * j] = (f32x4){bflo(w[j].x), bfhi(w[j].x), bflo(w[j].y), bfhi(w[j].y)}; v[2 * j + 1] = (f32x4){bflo(w[j].z), bfhi(w[j].z), bflo(w[j].w), bfhi(w[j].w)};
        if constexpr (!XIN_F32) { xi[2 * j] = (f32x4){bflo(xw[j].x), bfhi(xw[j].x), bflo(xw[j].y), bfhi(xw[j].y)}; xi[2 * j + 1] = (f32x4){bflo(xw[j].z), bfhi(xw[j].z), bflo(xw[j].w), bfhi(xw[j].w)}; } }
#pragma unroll
    for (int j = 0; j < 8; ++j) ss += (v[j].x * v[j].x + v[j].y * v[j].y) + (v[j].z * v[j].z + v[j].w * v[j].w);
    const float rstd = rsqrtf(wave_sum(ss) * (1.f / DM) + NORM_EPS);
    if constexpr (XOUT_F32) asm volatile("s_waitcnt vmcnt(0)" ::: "memory");
    float ss2 = 0.f;
#pragma unroll
    for (int j = 0; j < 8; ++j) { v[j] = xi[j] + v[j] * rstd * gp[j]; ss2 += (v[j].x * v[j].x + v[j].y * v[j].y) + (v[j].z * v[j].z + v[j].w * v[j].w); }
#pragma unroll
    for (int j = 0; j < 4; ++j) {
        if constexpr (XOUT_F32) { __builtin_nontemporal_store(v[2 * j], (GAS f32x4*)((float*)xout + 8 * lane + 512 * j)); __builtin_nontemporal_store(v[2 * j + 1], (GAS f32x4*)((float*)xout + 8 * lane + 512 * j + 4)); }
        else { v4u o; o.x = pk2(v[2 * j].x, v[2 * j].y); o.y = pk2(v[2 * j].z, v[2 * j].w); o.z = pk2(v[2 * j + 1].x, v[2 * j + 1].y); o.w = pk2(v[2 * j + 1].z, v[2 * j + 1].w);
            __builtin_nontemporal_store(o, (GAS v4u*)((bf16*)xout + 8 * lane + 512 * j)); } }
    if (has_next) {
        const float rstd2 = rsqrtf(wave_sum(ss2) * (1.f / DM) + NORM_EPS);
#pragma unroll
        for (int j = 0; j < 4; ++j) { const f32x4 g0 = gx[2 * j], g1 = gx[2 * j + 1], a = v[2 * j], c = v[2 * j + 1];
            v4u o; o.x = pk2(a.x * rstd2 * g0.x, a.y * rstd2 * g0.y); o.y = pk2(a.z * rstd2 * g0.z, a.w * rstd2 * g0.w); o.z = pk2(c.x * rstd2 * g1.x, c.y * rstd2 * g1.y); o.w = pk2(c.z * rstd2 * g1.z, c.w * rstd2 * g1.w);
            *(GAS v4u*)(hrow + 8 * lane + 512 * j) = o; }
    }
}

__device__ __forceinline__ void sc_load_cx(const bf16* row, int c0, float (&cx)[16]) {
#pragma unroll
    for (int hf = 0; hf < 2; ++hf) { float cc[8], xx[8]; unpack8(*(const GAS v4u*)(row + 1024 + c0 + 8 * hf), cc); unpack8(*(const GAS v4u*)(row + 2048 + c0 + 8 * hf), xx);
#pragma unroll
        for (int i = 0; i < 8; ++i) cx[8 * hf + i] = cc[i] * xx[i]; }
}
__device__ __forceinline__ void sc_phase(const Str st, const float* conv_sc, const float* sc_norm, int blk, int G) {
    PHASE_IDX();
    const bf16* psc = SPTR(st, bf16, OFF_PSC); bf16* mix = SPTR(st, bf16, OFF_MIX);
    const int c0 = 16 * lane;
    float w0[16], w1[16], w2[16], gn[16];
#pragma unroll
    for (int i = 0; i < 16; ++i) { w0[i] = conv_sc[c0 + i]; w1[i] = conv_sc[1024 + c0 + i]; w2[i] = conv_sc[2048 + c0 + i]; gn[i] = sc_norm[c0 + i]; }
    const int n = st.R / NGW, lr0 = gw * n;
    float cxp[16], cxc[16], cxn[16];
    { int start, len; seq_bounds(st.row0 + lr0, start, len);
      if (st.row0 + lr0 > start) sc_load_cx(psc + (size_t)(lr0 - 1) * NSC, c0, cxp); else {
#pragma unroll
          for (int i = 0; i < 16; ++i) cxp[i] = 0.f; }
      sc_load_cx(psc + (size_t)lr0 * NSC, c0, cxc); }
    v4u ra[4], rb[4], ba[2], bb[2];
#define SC_LOAD_B(dst, lrow) do { const int lq_ = (lrow) < st.R ? (lrow) : st.R - 1; const bf16* rp_ = psc + (size_t)lq_ * NSC + c0; dst[0] = *(const GAS v4u*)(rp_); dst[1] = *(const GAS v4u*)(rp_ + 8); } while (0)
#define SC_LOAD_CX(dst, lrow) do { const int lq_ = (lrow) < st.R ? (lrow) : st.R - 1; const bf16* rp_ = psc + (size_t)lq_ * NSC + c0; \
        dst[0] = *(const GAS v4u*)(rp_ + 1024); dst[1] = *(const GAS v4u*)(rp_ + 1032); dst[2] = *(const GAS v4u*)(rp_ + 2048); dst[3] = *(const GAS v4u*)(rp_ + 2056); } while (0)
#define SC_STEP(k_, BC, BN, RN, RNN) do { \
        const int lr = lr0 + (k_), r = st.row0 + lr; int start, len; seq_bounds(r, start, len); \
        const bool hn = r < start + len - 1; \
        SC_LOAD_B(BN, lr + 1); SC_LOAD_CX(RNN, lr + 2); \
        { float cc[8], xx[8]; unpack8(RN[0], cc); unpack8(RN[2], xx); \
          _Pragma("unroll") for (int i = 0; i < 8; ++i) cxn[i] = cc[i] * xx[i]; \
          unpack8(RN[1], cc); unpack8(RN[3], xx); \
          _Pragma("unroll") for (int i = 0; i < 8; ++i) cxn[8 + i] = cc[i] * xx[i]; } \
        float b[16]; { float t[8]; unpack8(BC[0], t); \
            _Pragma("unroll") for (int i = 0; i < 8; ++i) b[i] = t[i]; \
            unpack8(BC[1], t); \
            _Pragma("unroll") for (int i = 0; i < 8; ++i) b[8 + i] = t[i]; } \
        float y[16]; float ss = 0.f; \
        _Pragma("unroll") for (int i = 0; i < 16; ++i) { const float v = b[i] * (w0[i] * cxp[i] + w1[i] * cxc[i] + w2[i] * (hn ? cxn[i] : 0.f)); y[i] = v; ss += v * v; } \
        ss += __shfl_xor(ss, 1); ss += __shfl_xor(ss, 2); ss += __shfl_xor(ss, 4); \
        const float rstd = rsqrtf(ss * (1.f / 128.f) + NORM_EPS); \
        v4u o0, o1; \
        o0.x = pk2(y[0] * rstd * gn[0], y[1] * rstd * gn[1]); o0.y = pk2(y[2] * rstd * gn[2], y[3] * rstd * gn[3]); o0.z = pk2(y[4] * rstd * gn[4], y[5] * rstd * gn[5]); o0.w = pk2(y[6] * rstd * gn[6], y[7] * rstd * gn[7]); \
        o1.x = pk2(y[8] * rstd * gn[8], y[9] * rstd * gn[9]); o1.y = pk2(y[10] * rstd * gn[10], y[11] * rstd * gn[11]); o1.z = pk2(y[12] * rstd * gn[12], y[13] * rstd * gn[13]); o1.w = pk2(y[14] * rstd * gn[14], y[15] * rstd * gn[15]); \
        bf16* orow = mix + (size_t)lr * DM + 1024 + c0; \
        *(GAS v4u*)(orow) = o0; *(GAS v4u*)(orow + 8) = o1; \
        _Pragma("unroll") for (int i = 0; i < 16; ++i) { cxp[i] = hn ? cxc[i] : 0.f; cxc[i] = cxn[i]; }     \
        } while (0)
    SC_LOAD_B(ba, lr0); SC_LOAD_CX(ra, lr0 + 1);
    for (int k = 0; k < n; k += 2) { SC_STEP(k, ba, bb, ra, rb); SC_STEP(k + 1, bb, ba, rb, ra); }
#undef SC_STEP
#undef SC_LOAD_B
#undef SC_LOAD_CX
}

__device__ __forceinline__ void glu_fixup_phase(const Str st, const float* conv_ffn, int blk, int G) {
    PHASE_IDX();
    const float* SA = SPTR(st, float, OFF_SA); const float* SB = SPTR(st, float, OFF_SB); bf16* hmid = SPTR(st, bf16, OFF_HMID);
    const int NT = st.R / 256; constexpr int PER = DFF / 4;
    for (int it = gtid; it < NT * 2 * PER; it += NGT) {
        const int c4 = (it % PER) * 4, e = (it / PER) & 1, pm = it / (2 * PER);
        const int lr = pm * 256 + (e ? 255 : 0), r = st.row0 + lr; int start, len; seq_bounds(r, start, len);
        f32x4 pv, cv, nv, bv;
        if (e == 0) { cv = *(const GAS f32x4*)(SA + ((size_t)pm * 4 + 0) * DFF + c4); nv = *(const GAS f32x4*)(SA + ((size_t)pm * 4 + 1) * DFF + c4); bv = *(const GAS f32x4*)(SB + ((size_t)pm * 2) * DFF + c4);
            pv = (r > start) ? *(const GAS f32x4*)(SA + ((size_t)(pm - 1) * 4 + 3) * DFF + c4) : (f32x4){0.f, 0.f, 0.f, 0.f}; }
        else { pv = *(const GAS f32x4*)(SA + ((size_t)pm * 4 + 2) * DFF + c4); cv = *(const GAS f32x4*)(SA + ((size_t)pm * 4 + 3) * DFF + c4); bv = *(const GAS f32x4*)(SB + ((size_t)pm * 2 + 1) * DFF + c4);
            nv = (r < start + len - 1) ? *(const GAS f32x4*)(SA + ((size_t)(pm + 1) * 4 + 0) * DFF + c4) : (f32x4){0.f, 0.f, 0.f, 0.f}; }
        const f32x4 k0 = *(const GAS f32x4*)(conv_ffn + c4), k1 = *(const GAS f32x4*)(conv_ffn + DFF + c4), k2 = *(const GAS f32x4*)(conv_ffn + 2 * DFF + c4);
        float o[4];
#pragma unroll
        for (int j = 0; j < 4; ++j) { const float s = k0[j] * pv[j] + k1[j] * cv[j] + k2[j] * nv[j]; o[j] = siluf(s) * bv[j]; }
        v2u w; w.x = cvt2(o[0], o[1]); w.y = cvt2(o[2], o[3]);
        *(GAS v2u*)(hmid + (size_t)lr * DFF + c4) = w;
    }
}

typedef short bf16x8 __attribute__((ext_vector_type(8)));
typedef short s16x4 __attribute__((ext_vector_type(4)));
#define MFMA16(a, b, c) __builtin_amdgcn_mfma_f32_16x16x32_bf16((a), (b), (c), 0, 0, 0)
__device__ __forceinline__ v2u pack4(const f32x4 a) { v2u r; r.x = cvt2(a[0], a[1]); r.y = cvt2(a[2], a[3]); return r; }
__device__ __forceinline__ f32x4 unpack4(const v2u w) { return (f32x4){bflo(w.x), bfhi(w.x), bflo(w.y), bfhi(w.y)}; }
__device__ __forceinline__ bf16x8 pack_pair(const f32x4 a, const f32x4 b) { v4u p; p.x = cvt2(a[0], a[1]); p.y = cvt2(a[2], a[3]); p.z = cvt2(b[0], b[1]); p.w = cvt2(b[2], b[3]); return __builtin_bit_cast(bf16x8, p); }
__device__ __forceinline__ bf16x8 frag_plain(const LAS unsigned char* p) { return *(const LAS bf16x8*)p; }
__device__ __forceinline__ bf16x8 frag_2x8(const LAS unsigned char* p0, const LAS unsigned char* p1) { const v2u a = *(const LAS v2u*)p0, b = *(const LAS v2u*)p1; v4u r; r.x = a.x; r.y = a.y; r.z = b.x; r.w = b.y; return __builtin_bit_cast(bf16x8, r); }
__device__ __forceinline__ bf16x8 frag_tr(const LAS unsigned char* p0, const LAS unsigned char* p1) {
    const s16x4 a = __builtin_amdgcn_ds_read_tr16_b64_v4i16((LAS s16x4*)p0), b = __builtin_amdgcn_ds_read_tr16_b64_v4i16((LAS s16x4*)p1);
    return __builtin_shufflevector(a, b, 0, 1, 2, 3, 4, 5, 6, 7);
}
constexpr int PQB = 272, PXB = 144;
constexpr int TILE_Q = 64 * PQB, TILE_X = 64 * PXB;
constexpr int NUNIT = (TT / 64) * NHEAD;
constexpr size_t CHT = 64 * 128;
constexpr int PL_Q = 0, PL_K = TILE_Q, PL_V = 2 * TILE_Q, PL_MAT = 3 * TILE_Q;
constexpr int PL_GC = PL_MAT + 8 * TILE_X, PL_BE = PL_GC + 512, PL_CW = EXTRA_OFF, PL_END = PL_BE + 512;
static_assert(PL_END <= RING_BYTES, "prep LDS");

struct DeltaBufs { bf16* QN; bf16* KN; bf16* W0; bf16* W1; bf16* UT0; bf16* UT1; bf16* AQ0; bf16* AQ1; float* GC0; float* GC1; };
__device__ __forceinline__ DeltaBufs delta_bufs(const Str s) { return DeltaBufs{SPTR(s, bf16, OFF_QN), SPTR(s, bf16, OFF_KN), SPTR(s, bf16, OFF_W0), SPTR(s, bf16, OFF_W1), SPTR(s, bf16, OFF_UT0), SPTR(s, bf16, OFF_UT1), SPTR(s, bf16, OFF_AQ0), SPTR(s, bf16, OFF_AQ1), SPTR(s, float, OFF_GC0), SPTR(s, float, OFF_GC1)}; }

#define SCHED_FENCE() __builtin_amdgcn_sched_barrier(0)
template <bool DO_R, bool DO_X>
__device__ __forceinline__ void neumann_step(const LAS unsigned char* Rin, const LAS unsigned char* Xin, f32x4 (&accR)[2][2], f32x4 (&accX)[2][2], int jb, int ib, int c, int g, int q, int p) {
    bf16x8 A[2][2], BR[2][2], BX[2][2];
#pragma unroll
    for (int ks = 0; ks < 2; ++ks) {
#pragma unroll
        for (int a = 0; a < 2; ++a) { const LAS unsigned char* y = Xin + (32 * ks + 8 * g + q) * PXB + (32 * jb + 16 * a + 4 * p) * 2; A[ks][a] = frag_tr(y, y + 4 * PXB); }
#pragma unroll
        for (int b = 0; b < 2; ++b) { if (DO_R) BR[ks][b] = frag_plain(Rin + (32 * ib + 16 * b + c) * PXB + (32 * ks + 8 * g) * 2); if (DO_X) BX[ks][b] = frag_plain(Xin + (32 * ib + 16 * b + c) * PXB + (32 * ks + 8 * g) * 2); }
    }
#pragma unroll
    for (int a = 0; a < 2; ++a)
#pragma unroll
        for (int b = 0; b < 2; ++b) { if (DO_R) accR[a][b] = unpack4(*(const LAS v2u*)(Rin + (32 * ib + 16 * b + c) * PXB + (32 * jb + 16 * a + 4 * g) * 2)); accX[a][b] = (f32x4){0.f, 0.f, 0.f, 0.f}; }
    SCHED_FENCE();
#pragma unroll
    for (int ks = 0; ks < 2; ++ks)
#pragma unroll
        for (int a = 0; a < 2; ++a)
#pragma unroll
            for (int b = 0; b < 2; ++b) { if (DO_R) accR[a][b] = MFMA16(A[ks][a], BR[ks][b], accR[a][b]); if (DO_X) accX[a][b] = MFMA16(A[ks][a], BX[ks][b], accX[a][b]); }
    SCHED_FENCE();
}
__device__ __forceinline__ void mat_store(LAS unsigned char* O, const f32x4 (&acc)[2][2], int jb, int ib, int c, int g) {
#pragma unroll
    for (int a = 0; a < 2; ++a)
#pragma unroll
        for (int b = 0; b < 2; ++b) *(LAS v2u*)(O + (32 * ib + 16 * b + c) * PXB + (32 * jb + 16 * a + 4 * g) * 2) = pack4(acc[a][b]);
}

__device__ __forceinline__ void delta_prep(const Str st, const float* conv_qkv, const float* a_log, const float* dt_bias, LAS unsigned char* lds, int blk, int G) {
    PHASE_IDX();
    const bf16* pdn = SPTR(st, bf16, OFF_PDN); const DeltaBufs B = delta_bufs(st); const int row0 = st.row0;
    const int head = blk & 7, dirn = wave >> 2, wq = wave & 3, jb = wq >> 1, ib = wq & 1, c = lane & 15, g = lane >> 4, q = c >> 2, p = lane & 3;
    LAS float* CW = (LAS float*)(lds + PL_CW);
    for (int i = tid; i < 3 * 384; i += NWAVES * 64) { const int tap = i / 384, ch = i % 384; CW[i] = conv_qkv[tap * NQKV + (ch >> 7) * 1024 + head * 128 + (ch & 127)]; }
    LAS float* GCS = (LAS float*)(lds + PL_GC); LAS float* BES = (LAS float*)(lds + PL_BE);
    LAS unsigned char* MAT = lds + PL_MAT + dirn * 4 * TILE_X;
    LAS unsigned char* XA = MAT; LAS unsigned char* XB = MAT + TILE_X; LAS unsigned char* RA = MAT + 2 * TILE_X; LAS unsigned char* RB = MAT + 3 * TILE_X;
    const int gd = (tid >> 6) & 1;
    const float Ae = __expf(a_log[gd * 8 + head]), dtb = dt_bias[gd * 8 + head];
    bf16* Wg = dirn ? B.W1 : B.W0; bf16* UTg = dirn ? B.UT1 : B.UT0; bf16* AQg = dirn ? B.AQ1 : B.AQ0;
    const float SCALE = 0.08838834764831845f;
    const int gstep = G >> 3, gend = st.R / 64;
    constexpr int RPB = 784;
    LAS unsigned char* RAWT = lds + PL_MAT;
    static_assert(66 * RPB <= 8 * TILE_X, "raw tile fits the matrix region");
    v4u raw[7]; unsigned short ga = 0, gb = 0;
#define RAW_LOAD(gch_) do { const int t0_ = (gch_) * 64; int st_, ln_; seq_bounds(row0 + t0_, st_, ln_); st_ -= row0; int ty_ = tid; asm volatile("" : "+v"(ty_)); \
        _Pragma("unroll") for (int k = 0; k < 6; ++k) { const int i = ty_ + 512 * k, row = i / 48, cg = i % 48; \
            raw[k] = *(const GAS v4u*)(pdn + (size_t)(t0_ + row) * NDN + (cg >> 4) * 1024 + head * 128 + (cg & 15) * 8); } \
        if (tid < 96) { const int hr = tid / 48, cg = tid % 48, t = hr ? t0_ + 64 : t0_ - 1; const bool ok = hr ? (t < st_ + ln_) : (t >= st_); \
            raw[6] = ok ? *(const GAS v4u*)(pdn + (size_t)t * NDN + (cg >> 4) * 1024 + head * 128 + (cg & 15) * 8) : (v4u){0u, 0u, 0u, 0u}; } \
        if (tid < 128) { ga = pdn[(size_t)(t0_ + lane) * NDN + 4096 + gd * 8 + head]; gb = pdn[(size_t)(t0_ + lane) * NDN + 4096 + 16 + gd * 8 + head]; } } while (0)
    RAW_LOAD(blk >> 3);
    LDS_BAR();
    for (int gch = blk >> 3; gch < gend; gch += gstep) {
        const int u = gch * 8 + head;
        int tz = tid; asm volatile("" : "+v"(tz));
#pragma unroll
        for (int k = 0; k < 6; ++k) { const int i = tz + 512 * k, row = i / 48, cg = i % 48; *(LAS v4u*)(RAWT + (row + 1) * RPB + cg * 16) = raw[k]; }
        if (tid < 96) { const int hr = tid / 48, cg = tid % 48; *(LAS v4u*)(RAWT + (hr ? 65 : 0) * RPB + cg * 16) = raw[6]; }
        const unsigned short ga_c = ga, gb_c = gb;
        LDS_BAR();
        if (gch + gstep < gend) RAW_LOAD(gch + gstep);
#pragma unroll
        for (int k = 0; k < 6; ++k) {
            const int i = tz + 512 * k, row = i / 48, cg = i % 48, tensor = cg >> 4, c8 = (cg & 15) * 8;
            float xm[8], x0[8], xp[8];
            unpack8(*(const LAS v4u*)(RAWT + row * RPB + cg * 16), xm); unpack8(*(const LAS v4u*)(RAWT + (row + 1) * RPB + cg * 16), x0); unpack8(*(const LAS v4u*)(RAWT + (row + 2) * RPB + cg * 16), xp);
            float s[8]; float ss = 0.f;
            const LAS float* cw = CW + tensor * 128 + c8;
#pragma unroll
            for (int e = 0; e < 8; ++e) { const float v = cw[e] * xm[e] + cw[384 + e] * x0[e] + cw[768 + e] * xp[e]; s[e] = siluf(v); ss += s[e] * s[e]; }
            ss += __shfl_xor(ss, 1); ss += __shfl_xor(ss, 2); ss += __shfl_xor(ss, 4); ss += __shfl_xor(ss, 8);
            const float rn = tensor < 2 ? rsqrtf(ss + L2_EPS) : 1.f;
            v4u o; o.x = cvt2(s[0] * rn, s[1] * rn); o.y = cvt2(s[2] * rn, s[3] * rn); o.z = cvt2(s[4] * rn, s[5] * rn); o.w = cvt2(s[6] * rn, s[7] * rn);
            *(LAS v4u*)(lds + tensor * TILE_Q + row * PQB + c8 * 2) = o;
            if (tensor == 0) *(GAS v4u*)(B.QN + (size_t)u * CHT + row * 128 + c8) = o;
            if (tensor == 1) *(GAS v4u*)(B.KN + (size_t)u * CHT + row * 128 + c8) = o;
        }
        if (tid < 128) {
            const float a = bf1(ga_c), b = bf1(gb_c);
            const float xx = a + dtb, sp = xx > 20.f ? xx : log1pf(__expf(xx));
            float x = -Ae * sp;
#pragma unroll
            for (int o = 1; o < 64; o <<= 1) { const float up = __shfl_up(x, o), dn = __shfl_down(x, o); if (gd == 0) { if (lane >= o) x += up; } else { if (lane + o < 64) x += dn; } }
            GCS[gd * 64 + lane] = x; BES[gd * 64 + lane] = __builtin_amdgcn_rcpf(1.f + __expf(-b));
            const float gtot = __shfl(x, gd ? 0 : 63);
            float* gcp = (gd ? B.GC1 : B.GC0) + (size_t)u * 192;
            gcp[lane] = 0.08838834764831845f * __expf(x); gcp[64 + lane] = __expf(gtot - x); if (lane == 0) gcp[128] = __expf(gtot);
        }
        LDS_BAR();
        {
            f32x4 kk[2][2], kq[2][2];
#pragma unroll
            for (int a = 0; a < 2; ++a)
#pragma unroll
                for (int b = 0; b < 2; ++b) { kk[a][b] = (f32x4){0.f, 0.f, 0.f, 0.f}; kq[a][b] = (f32x4){0.f, 0.f, 0.f, 0.f}; }
#pragma unroll
            for (int kh = 0; kh < 2; ++kh) {
                bf16x8 A[2][2], Bk[2][2], Bq[2][2];
#pragma unroll
                for (int k2 = 0; k2 < 2; ++k2) { const int ks = 2 * kh + k2;
#pragma unroll
                    for (int a = 0; a < 2; ++a) A[k2][a] = frag_plain(lds + PL_K + (32 * jb + 16 * a + c) * PQB + (32 * ks + 8 * g) * 2);
#pragma unroll
                    for (int b = 0; b < 2; ++b) { Bk[k2][b] = frag_plain(lds + PL_K + (32 * ib + 16 * b + c) * PQB + (32 * ks + 8 * g) * 2); Bq[k2][b] = frag_plain(lds + PL_Q + (32 * ib + 16 * b + c) * PQB + (32 * ks + 8 * g) * 2); }
                }
                SCHED_FENCE();
#pragma unroll
                for (int k2 = 0; k2 < 2; ++k2)
#pragma unroll
                    for (int a = 0; a < 2; ++a)
#pragma unroll
                        for (int b = 0; b < 2; ++b) { kk[a][b] = MFMA16(A[k2][a], Bk[k2][b], kk[a][b]); kq[a][b] = MFMA16(A[k2][a], Bq[k2][b], kq[a][b]); }
                SCHED_FENCE();
            }
#pragma unroll
            for (int b = 0; b < 2; ++b) {
                const int i = 32 * ib + 16 * b + c; const float gci = GCS[dirn * 64 + i], bei = BES[dirn * 64 + i];
                v2u aqp[2];
#pragma unroll
                for (int a = 0; a < 2; ++a) {
                    const int j0 = 32 * jb + 16 * a + 4 * g; const f32x4 gcj = *(const LAS f32x4*)(GCS + dirn * 64 + j0);
                    f32x4 x1, r0, aq;
#pragma unroll
                    for (int r = 0; r < 4; ++r) { const int j = j0 + r; const bool strict = dirn ? (i < j) : (i > j), incl = strict || (i == j);
                        const float dec = incl ? __expf(gci - gcj[r]) : 0.f; const float av = strict ? bei * kk[a][b][r] * dec : 0.f;
                        x1[r] = -av; r0[r] = (i == j) ? 1.f : -av; aq[r] = kq[a][b][r] * SCALE * dec; }
                    *(LAS v2u*)(XA + i * PXB + j0 * 2) = pack4(x1); *(LAS v2u*)(RA + i * PXB + j0 * 2) = pack4(r0);
                    aqp[a] = pack4(aq);
                }
                *(GAS v4u*)(AQg + (size_t)u * 4096 + i * 64 + 32 * jb + 8 * g) = (v4u){aqp[0].x, aqp[0].y, aqp[1].x, aqp[1].y};
            }
        }
        LDS_BAR();
        f32x4 acc[2][2], acc2[2][2];
        neumann_step<false, true>(RA, XA, acc, acc2, jb, ib, c, g, q, p); mat_store(XB, acc2, jb, ib, c, g);
        LDS_BAR();
        neumann_step<true, true>(RA, XB, acc, acc2, jb, ib, c, g, q, p); mat_store(RB, acc, jb, ib, c, g); mat_store(XA, acc2, jb, ib, c, g);
        LDS_BAR();
        neumann_step<true, true>(RB, XA, acc, acc2, jb, ib, c, g, q, p); mat_store(RA, acc, jb, ib, c, g); mat_store(XB, acc2, jb, ib, c, g);
        LDS_BAR();
        neumann_step<true, true>(RA, XB, acc, acc2, jb, ib, c, g, q, p); mat_store(RB, acc, jb, ib, c, g); mat_store(XA, acc2, jb, ib, c, g);
        LDS_BAR();
        neumann_step<true, true>(RB, XA, acc, acc2, jb, ib, c, g, q, p); mat_store(RA, acc, jb, ib, c, g); mat_store(XB, acc2, jb, ib, c, g);
        LDS_BAR();
        neumann_step<true, false>(RA, XB, acc, acc2, jb, ib, c, g, q, p);
#pragma unroll
        for (int a = 0; a < 2; ++a) { const int j0 = 32 * jb + 16 * a + 4 * g; const f32x4 gcj = *(const LAS f32x4*)(GCS + dirn * 64 + j0), bej = *(const LAS f32x4*)(BES + dirn * 64 + j0);
#pragma unroll
            for (int b = 0; b < 2; ++b) { f32x4 t1, t2;
#pragma unroll
                for (int r = 0; r < 4; ++r) { t1[r] = acc[a][b][r] * bej[r]; t2[r] = t1[r] * __expf(gcj[r]); }
                acc[a][b] = t1; acc2[a][b] = t2; } }
        mat_store(RB, acc, jb, ib, c, g); mat_store(XA, acc2, jb, ib, c, g);
        LDS_BAR();
        {
            bf16x8 At[4][2], Bv[2][2];
#pragma unroll
            for (int a = 0; a < 4; ++a)
#pragma unroll
                for (int ks = 0; ks < 2; ++ks) At[a][ks] = frag_plain(RB + (16 * a + c) * PXB + (32 * ks + 8 * g) * 2);
#pragma unroll
            for (int et = 0; et < 2; ++et)
#pragma unroll
                for (int ks = 0; ks < 2; ++ks) { const LAS unsigned char* v = lds + PL_V + (32 * ks + 8 * g + q) * PQB + (32 * wq + 16 * et + 4 * p) * 2; Bv[et][ks] = frag_tr(v, v + 4 * PQB); }
            SCHED_FENCE();
            f32x4 o[2][4];
#pragma unroll
            for (int et = 0; et < 2; ++et)
#pragma unroll
                for (int a = 0; a < 4; ++a) { o[et][a] = (f32x4){0.f, 0.f, 0.f, 0.f};
#pragma unroll
                    for (int ks = 0; ks < 2; ++ks) o[et][a] = MFMA16(At[a][ks], Bv[et][ks], o[et][a]); }
            SCHED_FENCE();
#pragma unroll
            for (int et = 0; et < 2; ++et)
#pragma unroll
                for (int s = 0; s < 2; ++s) { const v2u lo = pack4(o[et][2 * s]), hi = pack4(o[et][2 * s + 1]);
                    *(GAS v4u*)(UTg + (size_t)u * CHT + (32 * wq + 16 * et + c) * 64 + 32 * s + 8 * g) = (v4u){lo.x, lo.y, hi.x, hi.y}; }
        }
        {
            bf16x8 Ak[2][2], Bt[4][2];
#pragma unroll
            for (int dt = 0; dt < 2; ++dt)
#pragma unroll
                for (int ks = 0; ks < 2; ++ks) { const LAS unsigned char* kp = lds + PL_K + (32 * ks + 8 * g + q) * PQB + (32 * wq + 16 * dt + 4 * p) * 2; Ak[dt][ks] = frag_tr(kp, kp + 4 * PQB); }
#pragma unroll
            for (int b = 0; b < 4; ++b)
#pragma unroll
                for (int ks = 0; ks < 2; ++ks) Bt[b][ks] = frag_plain(XA + (16 * b + c) * PXB + (32 * ks + 8 * g) * 2);
            SCHED_FENCE();
            f32x4 o[2][4];
#pragma unroll
            for (int dt = 0; dt < 2; ++dt)
#pragma unroll
                for (int b = 0; b < 4; ++b) { o[dt][b] = (f32x4){0.f, 0.f, 0.f, 0.f};
#pragma unroll
                    for (int ks = 0; ks < 2; ++ks) o[dt][b] = MFMA16(Ak[dt][ks], Bt[b][ks], o[dt][b]); }
            SCHED_FENCE();
#pragma unroll
            for (int b = 0; b < 4; ++b) { const v2u lo = pack4(o[0][b]), hi = pack4(o[1][b]);
                *(GAS v4u*)(Wg + (size_t)u * CHT + (16 * b + c) * 128 + 32 * wq + 8 * g) = (v4u){lo.x, lo.y, hi.x, hi.y}; }
        }
        LDS_BAR();
    }
#undef RAW_LOAD
}

constexpr int SQB = 272, SKB = 288, SAB = 160, SUB = 144;
constexpr int SL_W = 0, SL_Q = 64 * SQB, SL_K = 2 * 64 * SQB, SL_A = SL_K + 64 * SKB, SL_G = SL_A + 64 * SAB, SL_U = SL_G + 768, SL_BUF = SL_U + 64 * SUB;
static_assert(2 * SL_BUF <= RING_BYTES, "scan LDS");
constexpr int NLD = 19;
__device__ __forceinline__ void delta_scan(const Str st, LAS unsigned char* lds, int blk, int G) {
    if (blk < 0 || blk >= 64) return;
    PHASE_IDX();
    const DeltaBufs B = delta_bufs(st);
    const int sid = (blk & 7) | ((blk >> 4) << 3), half = (blk >> 3) & 1, seq = sid >> 4, dirn = (sid >> 3) & 1, head = sid & 7;
    const int len = st.R >> 1, start = seq * len, NC = len / 64, gch0 = start / 64;
    const bf16* Wg = dirn ? B.W1 : B.W0; bf16* UTg = dirn ? B.UT1 : B.UT0; const bf16* AQg = dirn ? B.AQ1 : B.AQ0; const float* GCg = dirn ? B.GC1 : B.GC0;
    const float SCALE = 0.08838834764831845f;
#define UNIT_OF(ci) ((size_t)((gch0 + (dirn ? NC - 1 - (ci) : (ci))) * 8 + head))
    if (wave >= 4) {
#define GLD(dst, base, voff, imm) asm volatile("s_nop 4\n\tglobal_load_dwordx4 %0, %1, %2 offset:" #imm : "=v"(dst) : "v"(voff), "s"(base) : "memory")
        const int lu = tid & 127;
#define PIECE_WQK(k_, h_) const int x = 512 * (h_) + lu + 128 * (k_), row = x >> 4, cc = x & 15
#define PIECE_A(k_, h_)   const int x = 256 * (h_) + lu + 128 * (k_), row = x >> 3, cc = x & 7
#define WR_WQK(b_, k_, h_, RW, RQ, RK) do { PIECE_WQK(k_, h_); *(LAS v4u*)(b_ + SL_W + row * SQB + cc * 16) = RW; *(LAS v4u*)(b_ + SL_K + row * SKB + cc * 16) = RK; \
            const int pb2 = ((cc & 12) * 8 + 16 * (cc & 1) + 4 * ((cc >> 1) & 1)) * 2; *(LAS v2u*)(b_ + SL_Q + row * SQB + pb2) = (v2u){RQ.x, RQ.y}; *(LAS v2u*)(b_ + SL_Q + row * SQB + pb2 + 16) = (v2u){RQ.z, RQ.w}; } while (0)
        if (wave >= 6) {
            const int oh = half ^ 1;
            const unsigned vo = (unsigned)lu * 16u + 4096u + 8192u * (unsigned)oh, voa = (unsigned)lu * 16u + 4096u + 4096u * (unsigned)oh;
            v4u R[14];
#define LO_ISSUE(ci) do { const size_t u_ = UNIT_OF(ci); const bf16* pw_ = Wg + u_ * CHT; const bf16* pq_ = B.QN + u_ * CHT; const bf16* pk_ = B.KN + u_ * CHT; const bf16* pa_ = AQg + u_ * 4096; \
                GLD(R[0], pw_, vo, -4096); GLD(R[4], pq_, vo, -4096); GLD(R[8], pk_, vo, -4096); GLD(R[1], pw_, vo, -2048); GLD(R[5], pq_, vo, -2048); GLD(R[9], pk_, vo, -2048); \
                GLD(R[2], pw_, vo, 0); GLD(R[6], pq_, vo, 0); GLD(R[10], pk_, vo, 0); GLD(R[3], pw_, vo, 2048); GLD(R[7], pq_, vo, 2048); GLD(R[11], pk_, vo, 2048); \
                GLD(R[12], pa_, voa, -4096); GLD(R[13], pa_, voa, -2048); } while (0)
#define LO_WAIT0() asm volatile("s_waitcnt vmcnt(0)" : "+v"(R[0]), "+v"(R[1]), "+v"(R[2]), "+v"(R[3]), "+v"(R[4]), "+v"(R[5]), "+v"(R[6]), "+v"(R[7]), "+v"(R[8]), "+v"(R[9]), "+v"(R[10]), "+v"(R[11]), "+v"(R[12]), "+v"(R[13]) :: "memory")
#define LO_WRITE(buf) do { LAS unsigned char* b_ = lds + (buf) * SL_BUF; \
                _Pragma("unroll") for (int k = 0; k < 4; ++k) WR_WQK(b_, k, oh, R[k], R[4 + k], R[8 + k]); \
                _Pragma("unroll") for (int k = 0; k < 2; ++k) { PIECE_A(k, oh); *(LAS v4u*)(b_ + SL_A + row * SAB + cc * 16) = R[12 + k]; } } while (0)
            LO_ISSUE(0); LO_WAIT0(); LO_WRITE(0);
            LDS_BAR();
            for (int ci = 0; ci < NC; ci += 2) {
                { const int cn = ci + 1 < NC ? ci + 1 : NC - 1; LO_ISSUE(cn); } LO_WAIT0(); LO_WRITE(1);
                LDS_BAR();
                { const int cn = ci + 2 < NC ? ci + 2 : NC - 1; LO_ISSUE(cn); } LO_WAIT0(); LO_WRITE(0);
                LDS_BAR();
            }
#undef LO_ISSUE
#undef LO_WAIT0
#undef LO_WRITE
        } else {
            const unsigned vo = (unsigned)lu * 16u + 4096u + 8192u * (unsigned)half, voa = (unsigned)lu * 16u + 4096u + 4096u * (unsigned)half, vou = (unsigned)lu * 16u + 4096u, vog = (unsigned)(lu < 48 ? lu : 47) * 16u;
            constexpr int NOWN = 19;
            v4u RA[NOWN], RB[NOWN];
#define LW_ISSUE(ci, R) do { const size_t u_ = UNIT_OF(ci); const bf16* pw_ = Wg + u_ * CHT; const bf16* pq_ = B.QN + u_ * CHT; const bf16* pk_ = B.KN + u_ * CHT; \
                const bf16* pa_ = AQg + u_ * 4096; const bf16* pu_ = UTg + u_ * CHT + half * 4096; const float* pg_ = GCg + u_ * 192; \
                GLD(R[0], pw_, vo, -4096); GLD(R[4], pq_, vo, -4096); GLD(R[8], pk_, vo, -4096); GLD(R[1], pw_, vo, -2048); GLD(R[5], pq_, vo, -2048); GLD(R[9], pk_, vo, -2048); \
                GLD(R[2], pw_, vo, 0); GLD(R[6], pq_, vo, 0); GLD(R[10], pk_, vo, 0); GLD(R[3], pw_, vo, 2048); GLD(R[7], pq_, vo, 2048); GLD(R[11], pk_, vo, 2048); \
                GLD(R[12], pa_, voa, -4096); GLD(R[13], pa_, voa, -2048); \
                GLD(R[14], pu_, vou, -4096); GLD(R[15], pu_, vou, -2048); GLD(R[16], pu_, vou, 0); GLD(R[17], pu_, vou, 2048); \
                GLD(R[18], pg_, vog, 0); } while (0)
#define LW_WAIT(N, R) asm volatile("s_waitcnt vmcnt(" #N ")" : "+v"(R[0]), "+v"(R[1]), "+v"(R[2]), "+v"(R[3]), "+v"(R[4]), "+v"(R[5]), "+v"(R[6]), "+v"(R[7]), "+v"(R[8]), \
                "+v"(R[9]), "+v"(R[10]), "+v"(R[11]), "+v"(R[12]), "+v"(R[13]), "+v"(R[14]), "+v"(R[15]), "+v"(R[16]), "+v"(R[17]), "+v"(R[18]) :: "memory")
#define LW_WRITE(buf, R) do { LAS unsigned char* b_ = lds + (buf) * SL_BUF; \
                _Pragma("unroll") for (int k = 0; k < 4; ++k) WR_WQK(b_, k, half, R[k], R[4 + k], R[8 + k]); \
                _Pragma("unroll") for (int k = 0; k < 2; ++k) { PIECE_A(k, half); *(LAS v4u*)(b_ + SL_A + row * SAB + cc * 16) = R[12 + k]; } \
                _Pragma("unroll") for (int k = 0; k < 4; ++k) { const int x = lu + 128 * k, row = x >> 3, cc = x & 7; *(LAS v4u*)(b_ + SL_U + row * SUB + cc * 16) = R[14 + k]; } \
                if (lu < 48) *(LAS v4u*)(b_ + SL_G + lu * 16) = R[18]; } while (0)
            LW_ISSUE(0, RA); LW_WAIT(0, RA); LW_WRITE(0, RA);
            LW_ISSUE(1, RA); LW_ISSUE(2, RB);
            LDS_BAR();
            for (int ci = 0; ci < NC; ci += 2) {
                LW_WAIT(19, RA);
                LW_WRITE(1, RA); { const int cn = ci + 3 < NC ? ci + 3 : NC - 1; LW_ISSUE(cn, RA); }
                LDS_BAR();
                LW_WAIT(19, RB);
                LW_WRITE(0, RB); { const int cn = ci + 4 < NC ? ci + 4 : NC - 1; LW_ISSUE(cn, RB); }
                LDS_BAR();
            }
            asm volatile("s_waitcnt vmcnt(0)" ::: "memory");
#undef LW_ISSUE
#undef LW_WAIT
#undef LW_WRITE
        }
#undef GLD
#undef PIECE_WQK
#undef PIECE_A
#undef WR_WQK
    } else {
        const int c = lane & 15, g = lane >> 4, q = c >> 2, p = lane & 3, e0 = 64 * half + 16 * wave;
        f32x4 S[8];
#pragma unroll
        for (int i = 0; i < 8; ++i) S[i] = (f32x4){0.f, 0.f, 0.f, 0.f};
        const int offA = c * SQB + 16 * g, offX = c * SAB + 16 * g, offT = (4 * g + q) * SKB + 8 * p;
#define LDWQ(ks, AW, AQ) do { _Pragma("unroll") for (int a = 0; a < 4; ++a) { AW[a] = frag_plain(b_ + SL_W + offA + a * 16 * SQB + (ks) * 64); AQ[a] = frag_plain(b_ + SL_Q + offA + a * 16 * SQB + (ks) * 64); } } while (0)
#define MMWQ(ks, AW, AQ) do { _Pragma("unroll") for (int a = 0; a < 4; ++a) { vw[a] = MFMA16(AW[a], Sb[ks], vw[a]); qs[a] = MFMA16(AQ[a], Sb[ks], qs[a]); } } while (0)
#define LDKN(dt0, AK) do { _Pragma("unroll") for (int d = 0; d < 4; ++d) _Pragma("unroll") for (int ks = 0; ks < 2; ++ks) { const LAS unsigned char* kp = b_ + SL_K + offT + ks * 32 * SKB + ((dt0) + d) * 32; AK[d][ks] = frag_tr(kp, kp + 16 * SKB); } } while (0)
#define MMKN(dt0, AK) do { _Pragma("unroll") for (int d = 0; d < 4; ++d) { S[(dt0) + d] = S[(dt0) + d] * gl; _Pragma("unroll") for (int ks = 0; ks < 2; ++ks) S[(dt0) + d] = MFMA16(AK[d][ks], Vd[ks], S[(dt0) + d]); } } while (0)
        LDS_BAR();
        for (int ci = 0; ci < NC; ++ci) {
            const size_t u = UNIT_OF(ci);
            const LAS unsigned char* b_ = lds + (ci & 1) * SL_BUF;
            bf16x8 Aw0[4], Aq0[4], Aw1[4], Aq1[4];
            LDWQ(0, Aw0, Aq0);
            bf16x8 Sb[4];
#pragma unroll
            for (int ks = 0; ks < 4; ++ks) Sb[ks] = pack_pair(S[2 * ks], S[2 * ks + 1]);
            f32x4 vw[4], qs[4];
#pragma unroll
            for (int a = 0; a < 4; ++a) { vw[a] = (f32x4){0.f, 0.f, 0.f, 0.f}; qs[a] = (f32x4){0.f, 0.f, 0.f, 0.f}; }
            LDWQ(1, Aw1, Aq1); SCHED_FENCE();
            MMWQ(0, Aw0, Aq0); SCHED_FENCE();
            LDWQ(2, Aw0, Aq0); SCHED_FENCE();
            MMWQ(1, Aw1, Aq1); SCHED_FENCE();
            LDWQ(3, Aw1, Aq1); SCHED_FENCE();
            MMWQ(2, Aw0, Aq0); SCHED_FENCE();
            bf16x8 Aa[4][2], Ak[4][2];
#pragma unroll
            for (int a = 0; a < 4; ++a)
#pragma unroll
                for (int ks = 0; ks < 2; ++ks) Aa[a][ks] = frag_plain(b_ + SL_A + offX + a * 16 * SAB + ks * 64);
            const LAS float* GCb = (const LAS float*)(b_ + SL_G);
            const float gl = GCb[128];
            f32x4 eq4[4], ed4[4]; v2u uc[4];
#pragma unroll
            for (int a = 0; a < 4; ++a) { eq4[a] = *(const LAS f32x4*)(GCb + 16 * a + 4 * g); ed4[a] = *(const LAS f32x4*)(GCb + 64 + 16 * a + 4 * g); uc[a] = *(const LAS v2u*)(b_ + SL_U + (16 * wave + c) * SUB + (32 * (a >> 1) + 8 * g + 4 * (a & 1)) * 2); }
            SCHED_FENCE();
            MMWQ(3, Aw1, Aq1); SCHED_FENCE();
            LDKN(0, Ak); SCHED_FENCE();
            f32x4 vn[4], vd[4];
#pragma unroll
            for (int a = 0; a < 4; ++a) { const f32x4 uu = unpack4(uc[a]);
#pragma unroll
                for (int r = 0; r < 4; ++r) { vn[a][r] = uu[r] - vw[a][r]; vd[a][r] = vn[a][r] * ed4[a][r]; qs[a][r] *= eq4[a][r]; } }
            bf16x8 Vb[2], Vd[2];
#pragma unroll
            for (int ks = 0; ks < 2; ++ks) { Vb[ks] = pack_pair(vn[2 * ks], vn[2 * ks + 1]); Vd[ks] = pack_pair(vd[2 * ks], vd[2 * ks + 1]); }
            SCHED_FENCE();
            MMKN(0, Ak); SCHED_FENCE();
            LDKN(4, Ak); SCHED_FENCE();
#pragma unroll
            for (int a = 0; a < 4; ++a) {
#pragma unroll
                for (int ks = 0; ks < 2; ++ks) qs[a] = MFMA16(Aa[a][ks], Vb[ks], qs[a]);
            }
            SCHED_FENCE();
            MMKN(4, Ak); SCHED_FENCE();
#pragma unroll
            for (int s = 0; s < 2; ++s) { const v2u lo = pack4(qs[2 * s]), hi = pack4(qs[2 * s + 1]); *(GAS v4u*)(UTg + u * CHT + (e0 + c) * 64 + 32 * s + 8 * g) = (v4u){lo.x, lo.y, hi.x, hi.y}; }
            LDS_BAR();
        }
#undef LDWQ
#undef MMWQ
#undef LDKN
#undef MMKN
    }
#undef UNIT_OF
}

__device__ __forceinline__ void combine_fast(const Str st, const float* dn_norm, LAS unsigned char* lds, int blk, int G) {
    PHASE_IDX();
    const DeltaBufs B = delta_bufs(st); const bf16* pdn = SPTR(st, bf16, OFF_PDN); bf16* mix = SPTR(st, bf16, OFF_MIX); const int nunit = (st.R / 64) * NHEAD;
    LAS unsigned char* T = lds + wave * 16384;
    LAS float* RS = (LAS float*)(lds + EXTRA_OFF + wave * 256);
    const int ck = lane & 15;
    float gn[8];
#pragma unroll
    for (int i = 0; i < 8; ++i) gn[i] = dn_norm[ck * 8 + i];
    for (int u = gw; u < nunit; u += NGW) {
        const int gch = u >> 3, head = u & 7;
        const bf16* f = B.UT0 + (size_t)u * CHT; const bf16* b = B.UT1 + (size_t)u * CHT;
        float ssa[8];
#pragma unroll
        for (int i = 0; i < 8; ++i) ssa[i] = 0.f;
        const int t8 = (lane & 7) * 8;
#pragma unroll 4
        for (int it = 0; it < 16; ++it) {
            const int e = it * 8 + (lane >> 3);
            float of[8], ob[8]; unpack8(*(const GAS v4u*)(f + e * 64 + t8), of); unpack8(*(const GAS v4u*)(b + e * 64 + t8), ob);
#pragma unroll
            for (int i = 0; i < 8; ++i) { const float o = of[i] + ob[i]; ssa[i] += o * o; const int tok = (t8 & 32) + 16 * (i >> 2) + ((t8 >> 1) & 12) + (i & 3);
                *(LAS unsigned short*)(T + tok * 256 + ((it ^ (tok & 15)) << 4) + (lane >> 3) * 2) = (unsigned short)(cvt2(o, 0.f) & 0xffffu); }
        }
#pragma unroll
        for (int i = 0; i < 8; ++i) { ssa[i] += __shfl_xor(ssa[i], 8); ssa[i] += __shfl_xor(ssa[i], 16); ssa[i] += __shfl_xor(ssa[i], 32); }
        if (lane < 8) {
#pragma unroll
            for (int i = 0; i < 8; ++i) RS[(t8 & 32) + 16 * (i >> 2) + ((t8 >> 1) & 12) + (i & 3)] = rsqrtf(ssa[i] * (1.f / 128.f) + NORM_EPS); }
        LDS_WAIT();
        v4u zq[4];
#pragma unroll
        for (int rr = 0; rr < 16; ++rr) {
            const int tok = 4 * rr + (lane >> 4); const size_t row = (size_t)gch * 64 + tok;
            if ((rr & 3) == 0) {
#pragma unroll
                for (int q4 = 0; q4 < 4; ++q4) zq[q4] = *(const GAS v4u*)(pdn + ((size_t)gch * 64 + 4 * (rr + q4) + (lane >> 4)) * NDN + 3072 + head * 128 + ck * 8); }
            float o[8], z[8]; unpack8(*(const LAS v4u*)(T + tok * 256 + ((ck ^ (tok & 15)) << 4)), o);
            unpack8(zq[rr & 3], z);
            const float rstd = RS[tok];
            float y[8];
#pragma unroll
            for (int i = 0; i < 8; ++i) y[i] = o[i] * rstd * gn[i] * siluf(z[i]);
            v4u w; w.x = cvt2(y[0], y[1]); w.y = cvt2(y[2], y[3]); w.z = cvt2(y[4], y[5]); w.w = cvt2(y[6], y[7]);
            *(GAS v4u*)(mix + row * DM + head * 128 + ck * 8) = w;
        }
        LDS_WAIT();
    }
}

struct Args { const float* in[17]; float* out; unsigned char* ws; };
__device__ __forceinline__ void norm0_phase(const Str st, const float* g, int blk, int G) {
    PHASE_IDX();
    bf16* H = SPTR(st, bf16, OFF_H);
    f32x4 gg[8];
#pragma unroll
    for (int j = 0; j < 8; ++j) gg[j] = *(const GAS f32x4*)(g + 4 * lane + 256 * j);
    for (int m = gw; m < st.R; m += NGW) norm_row(st.xin + (size_t)m * DM, gg, H + (size_t)m * DM, lane);
}
template <int MODE>
__device__ __forceinline__ void normres_phase(const Str st, size_t src_off, const float* gpost, float* out, const float* gnext, int blk, int G) {
    PHASE_IDX();
    const bf16* src = SPTR(st, bf16, src_off); bf16* H = SPTR(st, bf16, OFF_H); float* xout = out + (size_t)st.row0 * DM;
    f32x4 gp[8], gx[8];
#pragma unroll
    for (int j = 0; j < 8; ++j) { const int e = 8 * lane + 512 * (j >> 1) + 4 * (j & 1); gp[j] = *(const GAS f32x4*)(gpost + e); gx[j] = MODE != 2 ? *(const GAS f32x4*)(gnext + e) : (f32x4){0.f, 0.f, 0.f, 0.f}; }
    for (int m = gw; m < st.R; m += NGW) {
        float* slot = xout + (size_t)m * DM;
        if constexpr (MODE == 1) norm_res_row<true, false>(src + (size_t)m * DM, gp, st.xin + (size_t)m * DM, slot, MODE != 2, gx, H + (size_t)m * DM, lane);
        else if constexpr (MODE == 2) norm_res_row<false, true>(src + (size_t)m * DM, gp, slot, slot, MODE != 2, gx, H + (size_t)m * DM, lane);
        else norm_res_row<false, false>(src + (size_t)m * DM, gp, slot, slot, MODE != 2, gx, H + (size_t)m * DM, lane);
    }
}
__global__ void __launch_bounds__(NWAVES * 64, 2) enc_fwd(Args args) {
    extern __shared__ __attribute__((aligned(16))) unsigned char lds_raw[];
    LAS unsigned char* lds = (LAS unsigned char*)lds_raw;
    volatile LAS unsigned* MISC = (volatile LAS unsigned*)(lds + MISC_OFF);
    const int G = gridDim.x, blk = blockIdx.x;
    unsigned char* ws = args.ws;
    gu32* ctl = (gu32*)(ws + WS_CTL);
    for (int u = threadIdx.x; u < (LDS_BYTES - LDSCTL_OFF) / 4; u += NWAVES * 64) ((LAS unsigned*)(lds + LDSCTL_OFF))[u] = 0u;
    __syncthreads();
    XcdBarrier bar = xcd_barrier_post((unsigned*)(ctl + CW_BAR), MISC + 8);
#define GRID_BAR() xcd_barrier(bar)
#define WSP(T, off) ((T*)(ws + (off)))
    const Str SP{0, TP, ws + WS_ARENA_P, args.in[0]}, SS{TP, TSM, ws + WS_ARENA_S, args.in[1]};

#define PHASE_IN_R(st, L0_, L1_, Gs_, cs_)    do { pg8::Gemm g{SPTR(st, bf16, OFF_H), WSP(bf16, WS_WIN), (st).R, NIN, DM}; pg8::RangeOrder S; S.init((st).R, NIN, G, blk); S.L0 = (L0_); S.L1 = (L1_); S.Gs = (Gs_); S.cs = (cs_); \
          pg8::EpiBf16R E{SPTR(st, bf16, OFF_PDN), NDN, NDN / 256, SPTR(st, bf16, OFF_PSC), NSC}; \
          pg8::gemm_phase<pg8::EpiBf16R, pg8::RangeOrder, PG8_ALIGN, PG8_SP2>(lds + RING_OFF, g, S, E); } while (0)
#define PHASE_IN(st)    PHASE_IN_R(st, 0, ((st).R / 256) * (NIN / 256), G, blk)
#define PHASE_OUT(st)   do { pg8::Gemm g{SPTR(st, bf16, OFF_MIX), WSP(bf16, WS_WOUT), (st).R, DM, DM}; pg8::StaticOrder S; S.init((st).R, DM, G, blk); \
          pg8::EpiBf16R E{SPTR(st, bf16, OFF_M), DM, 1 << 20, SPTR(st, bf16, OFF_M), DM}; \
          pg8::gemm_phase<pg8::EpiBf16R, pg8::StaticOrder, PG8_ALIGN, PG8_SP2>(lds + RING_OFF, g, S, E); } while (0)
#define PHASE_UP(st, l, L0_, L1_, Gs_, cs_)   do { pg8::Gemm g{SPTR(st, bf16, OFF_H), WSP(bf16, WS_WUP), (st).R, NUP, DM}; pg8::RangeOrder S; S.init((st).R, NUP, G, blk); S.L0 = (L0_); S.L1 = (L1_); S.Gs = (Gs_); S.cs = (cs_); \
          pg8::EpiGlu E{SPTR(st, bf16, OFF_HMID), args.in[14] + (size_t)(l) * 3 * DFF, SPTR(st, float, OFF_SA), SPTR(st, float, OFF_SB), (LAS float*)(lds + EXTRA_OFF), DFF}; \
          pg8::gemm_phase<pg8::EpiGlu, pg8::RangeOrder, true, PG8_SP2>(lds + RING_OFF, g, S, E); } while (0)
#define PHASE_DOWN(st, L0_, L1_, Gs_, cs_)    do { pg8::Gemm g{SPTR(st, bf16, OFF_HMID), WSP(bf16, WS_WDN), (st).R, DM, DFF}; pg8::RangeOrder S; S.init((st).R, DM, G, blk); S.L0 = (L0_); S.L1 = (L1_); S.Gs = (Gs_); S.cs = (cs_); \
          pg8::EpiBf16R E{SPTR(st, bf16, OFF_F), DM, 1 << 20, SPTR(st, bf16, OFF_F), DM}; \
          pg8::gemm_phase<pg8::EpiBf16R, pg8::RangeOrder, PG8_ALIGN, PG8_SP2>(lds + RING_OFF, g, S, E); } while (0)
#define PHASE_SC(st, l)    sc_phase(st, args.in[8] + (size_t)(l) * 3 * 1024, args.in[9] + (size_t)(l) * 1024, blk, G)
#define PHASE_PREP(st, l)  delta_prep(st, args.in[4] + (size_t)(l) * 3 * NQKV, args.in[5] + (l) * 16, args.in[6] + (l) * 16, lds, blk, G)
#define PHASE_COMB(st, l)  combine_fast(st, args.in[7] + (l) * 128, lds, blk, G)
#define PHASE_NB(st, l)    do { if ((l) == 0) normres_phase<1>(st, OFF_M, args.in[11] + (size_t)(l) * DM, args.out, args.in[12] + (size_t)(l) * DM, blk, G); \
                                else normres_phase<0>(st, OFF_M, args.in[11] + (size_t)(l) * DM, args.out, args.in[12] + (size_t)(l) * DM, blk, G); } while (0)
#define PHASE_NC(st, l)    do { if ((l) + 1 < DEPTH) normres_phase<0>(st, OFF_F, args.in[16] + (size_t)(l) * DM, args.out, args.in[2] + (size_t)((l) + 1) * DM, blk, G); \
                                else normres_phase<2>(st, OFF_F, args.in[16] + (size_t)(l) * DM, args.out, nullptr, blk, G); } while (0)
#define PHASE_FIX(st, l)   glu_fixup_phase(st, args.in[14] + (size_t)(l) * 3 * DFF, blk, G)
#define CONVERT(l, which)  convert_weights(args.in[3] + (size_t)(l) * DM * INCOLS, args.in[10] + (size_t)(l) * DM * DM, args.in[13] + (size_t)(l) * DM * NUP, args.in[15] + (size_t)(l) * DFF * DM, which, ws, lds, blk, G)
    constexpr int UP_P = (TP / 256) * (NUP / 256), UP_P_HEAD = 192 * 14;
    constexpr int IN_S = (TSM / 256) * (NIN / 256), IN_S_HEAD = 192 * 17;
    constexpr int DN_S = (TSM / 256) * (DM / 256), DN_S_HEAD = 192 * 5;
    static_assert(DN_S - DN_S_HEAD == 64 && IN_S - IN_S_HEAD == 64 * 7, "unit split");

    CONVERT(0, 3);
    norm0_phase(SP, args.in[2], blk, G); norm0_phase(SS, args.in[2], blk, G);
    GRID_BAR();
    PHASE_IN(SP); GRID_BAR();
    PHASE_SC(SP, 0); GRID_BAR();
    PHASE_PREP(SP, 0); GRID_BAR();
    if (blk < 64) { delta_scan(SP, lds, blk, G); sub_barrier(bar, 64u); combine_fast(SP, args.in[7], lds, blk, 64); __syncthreads(); PHASE_IN_R(SS, IN_S_HEAD, IN_S, 64, blk); }
    else          { PHASE_IN_R(SS, 0, IN_S_HEAD, 192, blk - 64); }
    GRID_BAR();
    PHASE_OUT(SP); GRID_BAR();

    for (int l = 0; l < DEPTH; ++l) {
        PHASE_NB(SP, l); PHASE_SC(SS, l);
        GRID_BAR();
        PHASE_PREP(SS, l);
        GRID_BAR();
        if (blk < 64) { delta_scan(SS, lds, blk, G); PHASE_UP(SP, l, UP_P_HEAD, UP_P, 64, blk); }
        else          { PHASE_UP(SP, l, 0, UP_P_HEAD, 192, blk - 64); }
        GRID_BAR();
        PHASE_COMB(SS, l); PHASE_FIX(SP, l);
        GRID_BAR();
        PHASE_OUT(SS); PHASE_DOWN(SP, 0, (TP / 256) * (DM / 256), G, blk);
        GRID_BAR();
        PHASE_NB(SS, l); PHASE_NC(SP, l);
        if (l + 1 < DEPTH) CONVERT(l + 1, 1);
        GRID_BAR();
        if (l + 1 < DEPTH) {
            PHASE_IN_R(SP, 0, 7 * 256, G, blk); PHASE_IN_R(SP, 7 * 256, (TP / 256) * (NIN / 256), 64, ((blk & 7) < 2) ? ((blk >> 3) * 2 + (blk & 7)) : -1);
            PHASE_UP(SS, l, 0, (TSM / 256) * (NUP / 256), G, blk);
            GRID_BAR();
            PHASE_SC(SP, l + 1); PHASE_FIX(SS, l);
            GRID_BAR();
            PHASE_PREP(SP, l + 1);
            GRID_BAR();
            if (blk < 64) { delta_scan(SP, lds, blk, G); sub_barrier(bar, 64u * (unsigned)(l + 2)); combine_fast(SP, args.in[7] + (l + 1) * 128, lds, blk, 64); __syncthreads();
                            PHASE_DOWN(SS, DN_S_HEAD, DN_S, 64, blk); }
            else          { PHASE_DOWN(SS, 0, DN_S_HEAD, 192, blk - 64); }
            GRID_BAR();
            PHASE_NC(SS, l);
            CONVERT(l + 1, 2);
            GRID_BAR();
            PHASE_OUT(SP); PHASE_IN(SS);
            GRID_BAR();
        } else {
            PHASE_UP(SS, l, 0, (TSM / 256) * (NUP / 256), G, blk);
            GRID_BAR();
            PHASE_FIX(SS, l);
            GRID_BAR();
            PHASE_DOWN(SS, 0, DN_S, G, blk);
            GRID_BAR();
            PHASE_NC(SS, l);
        }
    }
    if (__hip_atomic_load((gu32*)(ctl + CW_BAR + XB_TMO), RLX_AGENT) != 0u) {
        const float q = __builtin_nanf(""); int tz = threadIdx.x; asm volatile("" : "+v"(tz));
        for (size_t i = (size_t)blk * (NWAVES * 64) + tz; i < (size_t)TT * DM; i += (size_t)G * NWAVES * 64) args.out[i] = q;
    }
}

extern "C" void kernel_launch(void* const* d_in, const int* in_sizes, int n_in, void* d_out, int out_size, void* d_ws, size_t ws_size, hipStream_t stream) {
    static int grid = 0;
    if (grid == 0) {
        if (n_in != 17 || out_size != TT * DM || ws_size < WS_END) { fprintf(stderr, "kernel_launch: unexpected shapes (n_in %d out %d ws %zu)\n", n_in, out_size, ws_size); grid = -1; return; }
        int dev = 0, cus = 0, per_cu = 0;
        if (hipGetDevice(&dev) != hipSuccess || hipDeviceGetAttribute(&cus, hipDeviceAttributeMultiprocessorCount, dev) != hipSuccess) { grid = -1; return; }
        if (hipFuncSetAttribute((const void*)enc_fwd, hipFuncAttributeMaxDynamicSharedMemorySize, LDS_BYTES) != hipSuccess) { fprintf(stderr, "kernel_launch: hipFuncSetAttribute failed\n"); grid = -1; return; }
        if (hipOccupancyMaxActiveBlocksPerMultiprocessor(&per_cu, (const void*)enc_fwd, NWAVES * 64, LDS_BYTES) != hipSuccess || per_cu < 1) { fprintf(stderr, "kernel_launch: occupancy query says %d\n", per_cu); grid = -1; (void)hipGetLastError(); return; }
        grid = cus;
    }
    if (grid < 0) return;
    if (hipMemsetAsync((char*)d_ws + WS_CTL, 0, CTL_ZERO_BYTES, stream) != hipSuccess) return;
    Args a{};
    for (int i = 0; i < 17; ++i) a.in[i] = (const float*)d_in[i];
    a.out = (float*)d_out; a.ws = (unsigned char*)d_ws;
    hipLaunchKernelGGL(enc_fwd, dim3(grid), dim3(NWAVES * 64), LDS_BYTES, stream, a);
}
```

```cpp
#include <hip/hip_runtime.h>
#include <cstdio>
#include <cstdint>
namespace pg8 {
#define PG8_LAS __attribute__((address_space(3)))
typedef unsigned short bf16_t;
typedef short bf16x8 __attribute__((ext_vector_type(8)));
typedef float f32x4 __attribute__((ext_vector_type(4)));
typedef unsigned u32x4 __attribute__((ext_vector_type(4)));
constexpr int BM = 256, BK = 64, HALF = 128, HTB = HALF * BK * 2  , STAGE_BYTES = 8 * HTB, NXCD = 8, WGM = 2;

__host__ __device__ __forceinline__ int lds_byte(int r, int c) { const int st = (r >> 4) * 2 + (c >> 5), rr = r & 15, cc = c & 31, ob = rr * 64 + cc * 2; return st * 1024 + (ob ^ (((ob >> 9) & 1) << 5)); }
__host__ __device__ __forceinline__ void stage_rc(int b, int& R, int& C) { const int st = b / 1024, sb = b % 1024, swz = sb ^ (((sb >> 9) & 1) << 5); R = (st >> 1) * 16 + swz / 64; C = (st & 1) * 32 + (swz % 64) / 2; }
__host__ __device__ __forceinline__ int perm32(int rho) { const int n = rho >> 4, i = rho & 15; return 8 * (i >> 2) + 4 * n + (i & 3); }

#ifndef WGM_UP
#define WGM_UP 4
#endif
#ifndef WGM_IN
#define WGM_IN 4
#endif
struct Unit { int pm, pn; };
struct Gemm { const bf16_t* A; const bf16_t* Bt; int M, N, K; };

struct StaticOrder {
    int nM, nN, nwg, G, c, wgm;
    __host__ __device__ void init(int M, int N, int G_, int c_) { nM = M / BM; nN = N / BM; nwg = nM * nN; G = G_; c = c_; wgm = WGM; }
    __host__ __device__ bool next(int i, Unit& u) const {
        const long L = (long)i * G + c; if (L >= nwg) return false;
        int wgid = (int)L; { const int q = nwg / NXCD, r = nwg % NXCD, xcd = wgid % NXCD, off = wgid / NXCD; wgid = (xcd < r ? xcd * (q + 1) : r * (q + 1) + (xcd - r) * q) + off; }
        const int nig = wgm * nN, gid = wgid / nig, fm = gid * wgm, gsz = (nM - fm) < wgm ? (nM - fm) : wgm;
        u.pm = fm + ((wgid % nig) % gsz); u.pn = (wgid % nig) / gsz; return true;
    }
    __device__ __forceinline__ void a_ready(const Unit&) const {}
    __device__ __forceinline__ void done(const Unit&) const {}
};
__device__ __forceinline__ unsigned cvt_pk_bf16(float lo, float hi) { unsigned r; asm volatile("v_cvt_pk_bf16_f32 %0, %1, %2" : "=v"(r) : "v"(lo), "v"(hi)); return r; }
typedef float f32x2 __attribute__((ext_vector_type(2)));
struct RangeOrder : StaticOrder {
    int L0, L1, Gs, cs;
    __device__ bool next(int i, Unit& u) const {
        const long L = (long)L0 + (long)i * Gs + cs; if (cs < 0 || L >= L1) return false;
        int wgid = (int)L; { const int q = nwg / NXCD, r = nwg % NXCD, xcd = wgid % NXCD, off = wgid / NXCD; wgid = (xcd < r ? xcd * (q + 1) : r * (q + 1) + (xcd - r) * q) + off; }
        const int nig = wgm * nN, gid = wgid / nig, fm = gid * wgm, gsz = (nM - fm) < wgm ? (nM - fm) : wgm;
        u.pm = fm + ((wgid % nig) % gsz); u.pn = (wgid % nig) / gsz; return true;
    }
};
struct EpiBf16R {
    static constexpr bool PERM = true, AFTER_DRAIN = false;
    bf16_t* O0; int ld0; int npn0; bf16_t* O1; int ld1;
    __device__ __forceinline__ void operator()(const f32x4 (&acc)[2][2][4][2], const Unit& u, int wr, int wc, int fr, int fq) const {
        const int lane = 16 * fq + fr, sr = lane >> 2, sq = lane & 3;
        const int src = (16 * sq + sr) << 2;
        const int row0 = u.pm * BM + wr * 64 + sr;
        bf16_t* base; int ldc, colt;
        if (u.pn < npn0) { base = O0; ldc = ld0; colt = u.pn * BM; } else { base = O1; ldc = ld1; colt = (u.pn - npn0) * BM; }
        const int col0 = colt + wc * 32 + 8 * sq;
#pragma unroll
        for (int ai = 0; ai < 2; ++ai)
#pragma unroll
            for (int m = 0; m < 4; ++m) { bf16_t* rowp = base + (size_t)(row0 + ai * HALF + m * 16) * ldc + col0;
#pragma unroll
                for (int bj = 0; bj < 2; ++bj) { const f32x4 v0 = acc[ai][bj][m][0], v1 = acc[ai][bj][m][1];
                    u32x4 w; w.x = cvt_pk_bf16(v0[0], v0[1]); w.y = cvt_pk_bf16(v0[2], v0[3]); w.z = cvt_pk_bf16(v1[0], v1[1]); w.w = cvt_pk_bf16(v1[2], v1[3]);
                    u32x4 t; t.x = (unsigned)__builtin_amdgcn_ds_bpermute(src, (int)w.x); t.y = (unsigned)__builtin_amdgcn_ds_bpermute(src, (int)w.y);
                    t.z = (unsigned)__builtin_amdgcn_ds_bpermute(src, (int)w.z); t.w = (unsigned)__builtin_amdgcn_ds_bpermute(src, (int)w.w);
                    *(u32x4*)(rowp + bj * HALF) = t; } }
    }
};
struct EpiGlu {
    static constexpr bool PERM = true, AFTER_DRAIN = false;
    bf16_t* HM; const float* cw; float* SA; float* SB; PG8_LAS float* XL; int dff;
    __device__ __forceinline__ void operator()(const f32x4 (&acc)[2][2][4][2], const Unit& u, int wr, int wc, int fr, int fq) const {
        const int chl = 32 * wc + 8 * fq, ch0 = 128 * u.pn + chl;
        f32x4 w0[2], w1[2], w2[2];
#pragma unroll
        for (int n = 0; n < 2; ++n) { w0[n] = *(const f32x4*)(cw + ch0 + 4 * n); w1[n] = *(const f32x4*)(cw + dff + ch0 + 4 * n); w2[n] = *(const f32x4*)(cw + 2 * dff + ch0 + 4 * n); }
#pragma unroll
        for (int ai = 0; ai < 2; ++ai) { const int bi = 2 * ai + wr;
            if (fr == 0) {
#pragma unroll
                for (int n = 0; n < 2; ++n) *(PG8_LAS f32x4*)(XL + bi * 128 + chl + 4 * n) = acc[ai][0][0][n]; }
            if (fr == 15) {
#pragma unroll
                for (int n = 0; n < 2; ++n) *(PG8_LAS f32x4*)(XL + 512 + bi * 128 + chl + 4 * n) = acc[ai][0][3][n]; }
        }
        if (wr == 0 && fr < 2) {
#pragma unroll
            for (int n = 0; n < 2; ++n) { *(f32x4*)(SA + ((size_t)u.pm * 4 + fr) * dff + ch0 + 4 * n) = acc[0][0][0][n]; if (fr == 0) *(f32x4*)(SB + ((size_t)u.pm * 2) * dff + ch0 + 4 * n) = acc[0][1][0][n]; } }
        if (wr == 1 && fr >= 14) {
#pragma unroll
            for (int n = 0; n < 2; ++n) { *(f32x4*)(SA + ((size_t)u.pm * 4 + fr - 12) * dff + ch0 + 4 * n) = acc[1][0][3][n]; if (fr == 15) *(f32x4*)(SB + ((size_t)u.pm * 2 + 1) * dff + ch0 + 4 * n) = acc[1][1][3][n]; } }
        asm volatile("s_waitcnt lgkmcnt(0)\n\ts_barrier" ::: "memory");
        f32x4 w0m[2], w2m[2];
#pragma unroll
        for (int n = 0; n < 2; ++n)
#pragma unroll
            for (int j = 0; j < 4; ++j) { w0m[n][j] = fr == 0 ? w0[n][j] : 0.f; w2m[n][j] = fr == 15 ? w2[n][j] : 0.f; }
#pragma unroll
        for (int ai = 0; ai < 2; ++ai) { const int bi = 2 * ai + wr;
            unsigned ow[4][4];
#pragma unroll
            for (int n = 0; n < 2; ++n) {
                const f32x4 pblk = bi > 0 ? *(const PG8_LAS f32x4*)(XL + 512 + (bi - 1) * 128 + chl + 4 * n) : (f32x4){0.f, 0.f, 0.f, 0.f};
                const f32x4 nblk = bi < 3 ? *(const PG8_LAS f32x4*)(XL + (bi + 1) * 128 + chl + 4 * n) : (f32x4){0.f, 0.f, 0.f, 0.f};
#pragma unroll
                for (int m = 0; m < 4; ++m) { float o[4]; f32x2 sv[2];
#pragma unroll
                    for (int jp = 0; jp < 4; jp += 2) {
                        const float c0 = acc[ai][0][m][n][jp], c1 = acc[ai][0][m][n][jp + 1];
                        const float p0 = m > 0 ? acc[ai][0][m > 0 ? m - 1 : 0][n][jp] : pblk[jp], p1 = m > 0 ? acc[ai][0][m > 0 ? m - 1 : 0][n][jp + 1] : pblk[jp + 1];
                        const float n0 = m < 3 ? acc[ai][0][m < 3 ? m + 1 : 3][n][jp] : nblk[jp], n1 = m < 3 ? acc[ai][0][m < 3 ? m + 1 : 3][n][jp + 1] : nblk[jp + 1];
                        float s0, s1;
                        asm("v_mul_f32 %0, %8, %2\n\tv_mul_f32 %1, %9, %3\n\t"
                            "v_fmac_f32_dpp %0, %2, %10 row_shr:1 row_mask:0xf bank_mask:0xf bound_ctrl:1\n\t"
                            "v_fmac_f32_dpp %1, %3, %11 row_shr:1 row_mask:0xf bank_mask:0xf bound_ctrl:1\n\t"
                            "v_fmac_f32_dpp %0, %2, %12 row_shl:1 row_mask:0xf bank_mask:0xf bound_ctrl:1\n\t"
                            "v_fmac_f32_dpp %1, %3, %13 row_shl:1 row_mask:0xf bank_mask:0xf bound_ctrl:1\n\t"
                            "v_fmac_f32_dpp %0, %4, %14 row_ror:1 row_mask:0xf bank_mask:0xf bound_ctrl:1\n\t"
                            "v_fmac_f32_dpp %1, %5, %15 row_ror:1 row_mask:0xf bank_mask:0xf bound_ctrl:1\n\t"
                            "v_fmac_f32_dpp %0, %6, %16 row_ror:15 row_mask:0xf bank_mask:0xf bound_ctrl:1\n\t"
                            "v_fmac_f32_dpp %1, %7, %17 row_ror:15 row_mask:0xf bank_mask:0xf bound_ctrl:1"
                            : "=&v"(s0), "=&v"(s1)
                            : "v"(c0), "v"(c1), "v"(p0), "v"(p1), "v"(n0), "v"(n1), "v"(w1[n][jp]), "v"(w1[n][jp + 1]), "v"(w0[n][jp]), "v"(w0[n][jp + 1]),
                              "v"(w2[n][jp]), "v"(w2[n][jp + 1]), "v"(w0m[n][jp]), "v"(w0m[n][jp + 1]), "v"(w2m[n][jp]), "v"(w2m[n][jp + 1]));
                        sv[jp >> 1] = (f32x2){s0, s1}; }
                    const f32x2 ta = sv[0] * -1.4426950408889634f, tb = sv[1] * -1.4426950408889634f;
                    const f32x2 da = (f32x2){__builtin_amdgcn_exp2f(ta.x), __builtin_amdgcn_exp2f(ta.y)} + 1.f, db = (f32x2){__builtin_amdgcn_exp2f(tb.x), __builtin_amdgcn_exp2f(tb.y)} + 1.f;
                    const f32x2 va = {acc[ai][1][m][n][0], acc[ai][1][m][n][1]}, vb = {acc[ai][1][m][n][2], acc[ai][1][m][n][3]};
                    const f32x2 pa = sv[0] * va, pb2 = sv[1] * vb;
                    const f32x2 oa = pa * (f32x2){__builtin_amdgcn_rcpf(da.x), __builtin_amdgcn_rcpf(da.y)}, ob = pb2 * (f32x2){__builtin_amdgcn_rcpf(db.x), __builtin_amdgcn_rcpf(db.y)};
                    o[0] = oa.x; o[1] = oa.y; o[2] = ob.x; o[3] = ob.y;
                    ow[m][2 * n] = cvt_pk_bf16(o[0], o[1]); ow[m][2 * n + 1] = cvt_pk_bf16(o[2], o[3]); }
            }
#pragma unroll
            for (int m = 0; m < 4; ++m) { u32x4 w; w.x = ow[m][0]; w.y = ow[m][1]; w.z = ow[m][2]; w.w = ow[m][3];
                *(u32x4*)(HM + (size_t)(u.pm * BM + 128 * ai + 64 * wr + 16 * m + fr) * dff + ch0) = w; }
        }
    }
};
template <class Epi, class Sched, bool ALIGN_EPI = false, bool SP2 = false>
__device__ __forceinline__ void gemm_phase(PG8_LAS unsigned char* lds, const Gemm g, const Sched& S, const Epi& E) {
    int tid_o = threadIdx.x; asm volatile("" : "+v"(tid_o)); const int tid = tid_o, wid = __builtin_amdgcn_readfirstlane(tid >> 6), lane = tid & 63, wr = wid >> 2, wc = wid & 3, fr = lane & 15, fq = lane >> 4;
    const int K = g.K, nt = K / BK;
    unsigned voffA[2], voffB[2];
#pragma unroll
    for (int i = 0; i < 2; ++i) { int R, C; stage_rc(tid * 16 + i * 8192, R, C); const int Rb = Epi::PERM ? ((R & ~31) + perm32(R & 31)) : R;
        voffA[i] = (unsigned)(R * K + C) * 2u; voffB[i] = (unsigned)(Rb * K + C) * 2u; }
    const size_t kstep = (size_t)(BK * 2);
    const size_t hstep = (size_t)HALF * K * 2;
    const size_t tstep = 2 * hstep;
    const unsigned ldsw = (unsigned)wid * 1024u;
    const int aoff = lds_byte(wr * 64 + fr, fq * 8), boff = lds_byte(wc * 32 + fr, fq * 8);
#define PG8_SA(b, h) (((b) * 2 + (h)) * HTB)
#define PG8_SB(b, h) ((4 + (b) * 2 + (h)) * HTB)
#define PG8_STAGE(bufoff, gbase, voff) do { _Pragma("unroll") for (int _i = 0; _i < 2; ++_i) \
        __builtin_amdgcn_global_load_lds((const unsigned*)((const char*)(gbase) + (voff)[_i]), (PG8_LAS unsigned*)(lds + (bufoff) + ldsw + _i * 8192), 16, 0, 0); } while (0)
#define PG8_LDA(dst, b, h) do { _Pragma("unroll") for (int m = 0; m < 4; ++m) _Pragma("unroll") for (int k = 0; k < 2; ++k) dst[m][k] = *(const PG8_LAS bf16x8*)(lds + PG8_SA(b, h) + aoff + m * 2048 + k * 1024); } while (0)
#define PG8_LDB(dst, b, h) do { _Pragma("unroll") for (int n = 0; n < 2; ++n) _Pragma("unroll") for (int k = 0; k < 2; ++k) dst[n][k] = *(const PG8_LAS bf16x8*)(lds + PG8_SB(b, h) + boff + n * 2048 + k * 1024); } while (0)
#define PG8_MMA(ai, bj, At, Bt) do { __builtin_amdgcn_s_setprio(1); _Pragma("unroll") for (int m = 0; m < 4; ++m) _Pragma("unroll") for (int n = 0; n < 2; ++n) _Pragma("unroll") for (int k = 0; k < 2; ++k) \
        acc[ai][bj][m][n] = __builtin_amdgcn_mfma_f32_16x16x32_bf16(Bt[n][k], At[m][k], acc[ai][bj][m][n], 0, 0, 0); __builtin_amdgcn_s_setprio(0); } while (0)
#define PG8_WAIT_V(n) asm volatile("s_waitcnt vmcnt(" #n ")" ::: "memory")
#define PG8_WAIT_L(n) asm volatile("s_waitcnt lgkmcnt(" #n ")" ::: "memory")
#define PG8_BAR __builtin_amdgcn_s_barrier()
#define PG8_SCHED __builtin_amdgcn_sched_barrier(0)
    Unit cur, nxt; int ui = 0;
    if (!S.next(0, cur)) return;
    f32x4 acc[2][2][4][2];
#pragma unroll
    for (int a = 0; a < 2; ++a)
#pragma unroll
        for (int b = 0; b < 2; ++b)
#pragma unroll
            for (int m = 0; m < 4; ++m)
#pragma unroll
                for (int n = 0; n < 2; ++n) acc[a][b][m][n] = (f32x4){0.f, 0.f, 0.f, 0.f};
    bf16x8 At[4][2], B0[2][2], B1[2][2];
    const char* cA = (const char*)g.A + (size_t)cur.pm * tstep; const char* cB = (const char*)g.Bt + (size_t)cur.pn * tstep;
    S.a_ready(cur);
    if constexpr (SP2) {
        PG8_STAGE(PG8_SB(0, 0), cB, voffB); PG8_STAGE(PG8_SB(0, 1), cB + hstep, voffB); PG8_STAGE(PG8_SA(0, 0), cA, voffA); PG8_STAGE(PG8_SA(0, 1), cA + hstep, voffA);
        if (wr == 1) PG8_BAR;
        PG8_WAIT_V(2); PG8_BAR;
        PG8_STAGE(PG8_SB(1, 0), cB + kstep, voffB); PG8_STAGE(PG8_SA(1, 0), cA + kstep, voffA); PG8_STAGE(PG8_SB(1, 1), cB + hstep + kstep, voffB);
        PG8_WAIT_V(6); PG8_BAR;
    } else {
        PG8_STAGE(PG8_SB(0, 0), cB, voffB); PG8_STAGE(PG8_SA(0, 0), cA, voffA); PG8_STAGE(PG8_SB(0, 1), cB + hstep, voffB); PG8_STAGE(PG8_SA(0, 1), cA + hstep, voffA);
        if (wr == 1) PG8_BAR;
        PG8_WAIT_V(4); PG8_BAR;
        PG8_STAGE(PG8_SB(1, 0), cB + kstep, voffB); PG8_STAGE(PG8_SA(1, 0), cA + kstep, voffA); PG8_STAGE(PG8_SB(1, 1), cB + hstep + kstep, voffB);
        PG8_WAIT_V(6); PG8_BAR;
    }
    for (;;) {
        const bool has_next = S.next(ui + 1, nxt);
        const char* nA = has_next ? (const char*)g.A + (size_t)nxt.pm * tstep : cA; const char* nB = has_next ? (const char*)g.Bt + (size_t)nxt.pn * tstep : cB;
        for (int t = 0; t < nt; t += 2) {
            const bool last = (t == nt - 2);
            const char* a1 = cA + (size_t)(t + 1) * kstep;
            const char* a2 = last ? nA : cA + (size_t)(t + 2) * kstep; const char* b2 = last ? nB : cB + (size_t)(t + 2) * kstep;
            const char* a3 = a2 + kstep; const char* b3 = b2 + kstep;
            if (last && has_next) S.a_ready(nxt);
            if constexpr (SP2) {
            PG8_LDB(B0, 0, 0); PG8_LDB(B1, 0, 1); PG8_SCHED; PG8_LDA(At, 0, 0); PG8_STAGE(PG8_SA(1, 1), a1 + hstep, voffA);
            PG8_WAIT_V(8); PG8_WAIT_L(0); PG8_BAR; PG8_MMA(0, 0, At, B0); PG8_MMA(0, 1, At, B1); PG8_BAR; PG8_SCHED;
            PG8_LDA(At, 0, 1); PG8_STAGE(PG8_SB(0, 0), b2, voffB); PG8_STAGE(PG8_SB(0, 1), b2 + hstep, voffB); PG8_STAGE(PG8_SA(0, 0), a2, voffA);
            PG8_WAIT_V(8); PG8_WAIT_L(0); PG8_BAR; PG8_MMA(1, 0, At, B0); PG8_MMA(1, 1, At, B1); PG8_BAR; PG8_SCHED;
            PG8_LDB(B0, 1, 0); PG8_LDB(B1, 1, 1); PG8_SCHED; PG8_LDA(At, 1, 0); PG8_STAGE(PG8_SA(0, 1), a2 + hstep, voffA);
            PG8_WAIT_V(8); PG8_WAIT_L(0); PG8_BAR; PG8_MMA(0, 0, At, B0); PG8_MMA(0, 1, At, B1); PG8_BAR; PG8_SCHED;
            PG8_LDA(At, 1, 1); PG8_STAGE(PG8_SB(1, 0), b3, voffB); PG8_STAGE(PG8_SB(1, 1), b3 + hstep, voffB); PG8_STAGE(PG8_SA(1, 0), a3, voffA);
            PG8_WAIT_V(8); PG8_WAIT_L(0); PG8_BAR; PG8_MMA(1, 0, At, B0); PG8_MMA(1, 1, At, B1); PG8_BAR; PG8_SCHED;
            } else {
            PG8_LDB(B0, 0, 0); PG8_SCHED; PG8_LDA(At, 0, 0); PG8_STAGE(PG8_SA(1, 1), a1 + hstep, voffA);
            PG8_WAIT_L(8); PG8_BAR; PG8_WAIT_L(0); PG8_MMA(0, 0, At, B0); PG8_BAR; PG8_SCHED;
            PG8_LDB(B1, 0, 1); PG8_STAGE(PG8_SB(0, 0), b2, voffB);
            PG8_BAR; PG8_WAIT_L(0); PG8_MMA(0, 1, At, B1); PG8_BAR;
            PG8_LDA(At, 0, 1); PG8_STAGE(PG8_SA(0, 0), a2, voffA);
            PG8_BAR; PG8_WAIT_L(0); PG8_MMA(1, 0, At, B0); PG8_BAR; PG8_SCHED;
            PG8_STAGE(PG8_SB(0, 1), b2 + hstep, voffB);
            PG8_WAIT_V(6); PG8_BAR; PG8_MMA(1, 1, At, B1); PG8_BAR;
            PG8_LDB(B0, 1, 0); PG8_SCHED; PG8_LDA(At, 1, 0); PG8_STAGE(PG8_SA(0, 1), a2 + hstep, voffA);
            PG8_WAIT_L(8); PG8_BAR; PG8_WAIT_L(0); PG8_MMA(0, 0, At, B0); PG8_BAR; PG8_SCHED;
            PG8_LDB(B1, 1, 1); PG8_STAGE(PG8_SB(1, 0), b3, voffB);
            PG8_BAR; PG8_WAIT_L(0); PG8_MMA(0, 1, At, B1); PG8_BAR;
            PG8_LDA(At, 1, 1); PG8_STAGE(PG8_SA(1, 0), a3, voffA);
            PG8_BAR; PG8_WAIT_L(0); PG8_MMA(1, 0, At, B0); PG8_BAR; PG8_SCHED;
            PG8_STAGE(PG8_SB(1, 1), b3 + hstep, voffB);
            PG8_WAIT_V(6); PG8_BAR; PG8_MMA(1, 1, At, B1); PG8_BAR;
            }
        }
        if constexpr (ALIGN_EPI) { if (wr == 0) PG8_BAR; }
        if constexpr (!Epi::AFTER_DRAIN) { E(acc, cur, wr, wc, fr, fq); S.done(cur); }
        if (!has_next) break;
#pragma unroll
        for (int a = 0; a < 2; ++a)
#pragma unroll
            for (int b = 0; b < 2; ++b)
#pragma unroll
                for (int m = 0; m < 4; ++m)
#pragma unroll
                    for (int n = 0; n < 2; ++n) acc[a][b][m][n] = (f32x4){0.f, 0.f, 0.f, 0.f};
        cur = nxt; cA = nA; cB = nB; ++ui;
        if constexpr (ALIGN_EPI) { if (wr == 1) PG8_BAR; }
    }
    PG8_WAIT_V(0);
    if constexpr (!ALIGN_EPI) { if (wr == 0) PG8_BAR; }
    PG8_BAR;
    if constexpr (Epi::AFTER_DRAIN) { E.fused(acc, cur, wr, wc, fr, fq, lds, wid, lane); S.done(cur); }
#undef PG8_SA
#undef PG8_SB
#undef PG8_STAGE
#undef PG8_LDA
#undef PG8_LDB
#undef PG8_MMA
#undef PG8_WAIT_V
#undef PG8_WAIT_L
#undef PG8_BAR
#undef PG8_SCHED
}
}
#ifndef PG8_SP2
#define PG8_SP2 true
#endif
#ifndef PG8_ALIGN
#define PG8_ALIGN true
#endif

constexpr int NWAVES = 8;
constexpr int DM = 2048, DEPTH = 4, TP = 16384, TSM = 32768, TT = TP + TSM;
constexpr int NQKV = 3072, NDNR = 4128, NDN = 4352, NSC = 3072, NIN = NDN + NSC, INCOLS = 7200;
constexpr int DFF = 5632, NUP = 2 * DFF;
constexpr int NHEAD = 8, HD = 128, CH = 64;
constexpr int SECROWS = 16384, NSEC = 3;
constexpr float NORM_EPS = 1e-6f, L2_EPS = 1e-6f;

constexpr size_t MiB = 1u << 20;
constexpr size_t WS_CTL = 0, CTL_ZERO_BYTES = 1 * MiB;
constexpr size_t WS_WIN = 1 * MiB, WS_WOUT = 30 * MiB, WS_WUP = 38 * MiB, WS_WDN = 82 * MiB;
constexpr size_t OFF_H = 0, OFF_QN = 0, OFF_KN = 2048, OFF_MIX = 4096, OFF_PDN = 8192, OFF_M = 8192, OFF_HMID = 4096, OFF_PSC = 16896, OFF_W0 = 16896, OFF_W1 = 18944, OFF_UT0 = 20992, OFF_F = 16896;
constexpr size_t OFF_UT1 = 23040, OFF_SA = 23040, OFF_SB = 23392, OFF_AQ0 = 25088, OFF_AQ1 = 26112, OFF_GC0 = 27136, OFF_GC1 = 27232, ROW_BYTES = 27328;
constexpr size_t WS_ARENA_P = 105 * MiB, WS_ARENA_S = WS_ARENA_P + ROW_BYTES * TP, WS_END = WS_ARENA_S + ROW_BYTES * TSM;
static_assert(WS_WIN + (size_t)NIN * DM * 2 <= WS_WOUT && WS_WOUT + (size_t)DM * DM * 2 <= WS_WUP && WS_WUP + (size_t)NUP * DM * 2 <= WS_WDN && WS_WDN + (size_t)DM * DFF * 2 <= WS_ARENA_P, "weights map");
static_assert(WS_END <= 1408 * MiB && OFF_HMID + 11264 <= OFF_F && OFF_SB + 176 <= OFF_AQ0 && OFF_M + 4096 <= OFF_PSC, "arena map");
constexpr int CW_BAR = 4096;

constexpr int RING_OFF = 0, RING_BYTES = 147456;
constexpr int EXTRA_OFF = RING_BYTES, LDSCTL_OFF = RING_BYTES + 8192, MISC_OFF = LDSCTL_OFF + 320;
constexpr int LDS_BYTES = RING_BYTES + 8192 + 512;

#define GAS __attribute__((address_space(1)))
#define LAS __attribute__((address_space(3)))
typedef unsigned short bf16;
typedef unsigned v4u __attribute__((ext_vector_type(4)));
typedef unsigned v2u __attribute__((ext_vector_type(2)));
typedef float f32x4 __attribute__((ext_vector_type(4)));
typedef GAS unsigned gu32;
#define RLX_AGENT __ATOMIC_RELAXED, __HIP_MEMORY_SCOPE_AGENT
#define LDS_WAIT() asm volatile("s_waitcnt lgkmcnt(0)" ::: "memory")
#define VM_WAIT() asm volatile("s_waitcnt vmcnt(0)" ::: "memory")
#define LDS_BAR() asm volatile("s_waitcnt lgkmcnt(0)\n\ts_barrier" ::: "memory")
typedef __bf16 bf2_t __attribute__((ext_vector_type(2)));
typedef float f2_t __attribute__((ext_vector_type(2)));
__device__ __forceinline__ unsigned cvt2(float a, float b) { const f2_t v = {a, b}; return __builtin_bit_cast(unsigned, __builtin_convertvector(v, bf2_t)); }
__device__ __forceinline__ unsigned f2bf(float f) { unsigned u = __builtin_bit_cast(unsigned, f); return (u + 0x7fffu + ((u >> 16) & 1u)) >> 16; }
__device__ __forceinline__ unsigned pk2(float lo, float hi) { return cvt2(lo, hi); }
__device__ __forceinline__ float bflo(unsigned u) { return __builtin_bit_cast(float, u << 16); }
__device__ __forceinline__ float bfhi(unsigned u) { return __builtin_bit_cast(float, u & 0xffff0000u); }
__device__ __forceinline__ float bf1(bf16 b) { return __builtin_bit_cast(float, ((unsigned)b) << 16); }
__device__ __forceinline__ void unpack8(const v4u w, float (&f)[8]) { f[0] = bflo(w.x); f[1] = bfhi(w.x); f[2] = bflo(w.y); f[3] = bfhi(w.y); f[4] = bflo(w.z); f[5] = bfhi(w.z); f[6] = bflo(w.w); f[7] = bfhi(w.w); }
__device__ __forceinline__ float wave_sum(float v) {
#pragma unroll
    for (int o = 1; o < 64; o <<= 1) v += __shfl_xor(v, o);
    return v;
}
__device__ __forceinline__ float siluf(float x) { return x * __builtin_amdgcn_rcpf(1.f + __expf(-x)); }
__device__ __forceinline__ void seq_bounds(int r, int& start, int& len) {
    if (r < TP) { len = 8192; start = r & ~8191; } else { len = 16384; start = TP + ((r - TP) & ~16383); }
}
#define XB_TMO      128
#define XB_XCNT(j)  (256  + 64 * (j))
#define XB_XSUB(j)  (1280 + 64 * (j))
#define XB_XGEN(j)  (2304 + 64 * (j))
#define XB_TOP      3328
#define XB_TOPGEN   3392
#define XB_SUBW     3456
#define XCD_BAR_WORDS 3456
#define XB_SPIN_CAP (1u << 18)

__device__ __forceinline__ unsigned xb_ld(unsigned* p)              { return __hip_atomic_load(p, __ATOMIC_RELAXED, __HIP_MEMORY_SCOPE_AGENT); }
__device__ __forceinline__ unsigned xb_add(unsigned* p, unsigned v) { return __hip_atomic_fetch_add(p, v, __ATOMIC_RELAXED, __HIP_MEMORY_SCOPE_AGENT); }
__device__ __forceinline__ unsigned xb_xcc_id() { return (unsigned)__builtin_amdgcn_s_getreg((3 << 11) | 20) & 0xFu; }
#define XB_SPIN(cond, bar) do { unsigned _sp = 0; while (cond) { __builtin_amdgcn_s_sleep(1); \
    if ((++_sp & 255u) == 0u) { if (xb_ld(&(bar)[XB_TMO])) break; if (_sp > XB_SPIN_CAP) { atomicAdd(&(bar)[XB_TMO], 1u); break; } } } } while (0)

struct XcdBarrier {
    unsigned* bar; unsigned x;
    volatile LAS unsigned* st;
};

__device__ __forceinline__ XcdBarrier xcd_barrier_post(unsigned* bar, volatile LAS unsigned* st) {
    XcdBarrier b; b.bar = bar; b.x = xb_xcc_id(); b.st = st;
    if (threadIdx.x == 0) (void)xb_add(&bar[XB_XCNT(b.x)], 1u);
    return b;
}
__device__ __forceinline__ void xcd_barrier_complete(unsigned* bar, unsigned x, unsigned& nloc, unsigned& nx) {
    const unsigned G = gridDim.x * gridDim.y * gridDim.z;
    unsigned sum, cnt, mine, sp = 0u;
    for (;;) {
        sum = 0u; cnt = 0u; mine = 0u;
#pragma unroll
        for (unsigned j = 0; j < 16; ++j) { const unsigned c = xb_ld(&bar[XB_XCNT(j)]); sum += c; cnt += (c > 0u) ? 1u : 0u; mine = (j == x) ? c : mine; }
        if (sum == G) break;
        __builtin_amdgcn_s_sleep(1);
        if ((++sp & 255u) == 0u) { if (xb_ld(&bar[XB_TMO])) break; if (sp > XB_SPIN_CAP) { atomicAdd(&bar[XB_TMO], 1u); break; } }
    }
    nloc = mine > 0u ? mine : 1u; nx = cnt > 0u ? cnt : 1u;
}

__device__ __forceinline__ void xcd_barrier(const XcdBarrier& b) {
    asm volatile("s_waitcnt vmcnt(0)" ::: "memory");
    __syncthreads();
    if (threadIdx.x == 0) {
        unsigned* bar = b.bar; unsigned bx = b.x;
        asm volatile("" : "+s"(bar), "+s"(bx));
        __builtin_amdgcn_s_waitcnt(0);
        unsigned nloc = b.st[0], nx = b.st[1];
        if (nloc == 0u) { xcd_barrier_complete(bar, bx, nloc, nx); b.st[0] = nloc; b.st[1] = nx; }
        const unsigned old = xb_add(&bar[XB_XSUB(bx)], 1u);
        const unsigned gen = old / nloc;
        if (old + 1u == (gen + 1u) * nloc) {
            __builtin_amdgcn_fence(__ATOMIC_RELEASE, "agent");
            asm volatile("s_waitcnt vmcnt(0)" ::: "memory");
            const unsigned og = xb_add(&bar[XB_TOP], 1u);
            const unsigned tg = og / nx;
            if (og + 1u == (tg + 1u) * nx) xb_add(&bar[XB_TOPGEN], 1u);
            else XB_SPIN(xb_ld(&bar[XB_TOPGEN]) == tg, bar);
            __builtin_amdgcn_fence(__ATOMIC_ACQUIRE, "agent");
            xb_add(&bar[XB_XGEN(bx)], 1u);
            asm volatile("s_waitcnt vmcnt(0)" ::: "memory");
        } else {
            XB_SPIN(xb_ld(&bar[XB_XGEN(bx)]) == gen, bar);
            __builtin_amdgcn_fence(__ATOMIC_ACQUIRE, "agent");
            asm volatile("s_waitcnt vmcnt(0)" ::: "memory");
        }
    }
    __syncthreads();
}
__device__ __forceinline__ void sub_barrier(const XcdBarrier& b, unsigned target) {
    asm volatile("s_waitcnt vmcnt(0)" ::: "memory");
    __syncthreads();
    if (threadIdx.x == 0) {
        unsigned* bar = b.bar; asm volatile("" : "+s"(bar));
        __builtin_amdgcn_fence(__ATOMIC_RELEASE, "agent");
        asm volatile("s_waitcnt vmcnt(0)" ::: "memory");
        (void)xb_add(&bar[XB_SUBW], 1u);
        XB_SPIN(xb_ld(&bar[XB_SUBW]) < target, bar);
        __builtin_amdgcn_fence(__ATOMIC_ACQUIRE, "agent");
        asm volatile("s_waitcnt vmcnt(0)" ::: "memory");
    }
    __syncthreads();
}
struct Str { int row0, R; unsigned char* base; const float* xin; };
#define SPTR(s, T, OFF) ((T*)((s).base + (size_t)(OFF) * (s).R))
#define PHASE_IDX() int tid_ = threadIdx.x; asm volatile("" : "+v"(tid_)); const int tid = tid_, lane = tid & 63, wave = __builtin_amdgcn_readfirstlane(tid >> 6); \
    const int gw = blk * NWAVES + wave, NGW = G * NWAVES, gtid = blk * (NWAVES * 64) + tid, NGT = G * NWAVES * 64; (void)lane; (void)gw; (void)NGW; (void)gtid; (void)NGT;
struct TrItem { const float* W; bf16* WT; int K, N, k0, n0, roff; };
__device__ __forceinline__ void tr_load(const TrItem t, f32x4 (&v)[8], int lane) {
#pragma unroll
    for (int i = 0; i < 8; ++i) v[i] = *(const GAS f32x4*)(t.W + (size_t)(t.k0 + 8 * i + (lane >> 3)) * t.N + t.n0 + (lane & 7) * 4);
}
__device__ __forceinline__ void tr_store(const TrItem t, const f32x4 (&v)[8], LAS float* scr, int lane) {
#pragma unroll
    for (int i = 0; i < 8; ++i) { const int kk = 8 * i + (lane >> 3), c4 = (lane & 7) * 4; scr[kk * 33 + c4] = v[i].x; scr[kk * 33 + c4 + 1] = v[i].y; scr[kk * 33 + c4 + 2] = v[i].z; scr[kk * 33 + c4 + 3] = v[i].w; }
    LDS_WAIT(); asm volatile("" ::: "memory");
    const int c = lane & 7;
#pragma unroll
    for (int j = 0; j < 4; ++j) { const int n = (lane >> 3) + 8 * j; const LAS float* s = scr + (8 * c) * 33 + n;
        v4u o; o.x = pk2(s[0 * 33], s[1 * 33]); o.y = pk2(s[2 * 33], s[3 * 33]); o.z = pk2(s[4 * 33], s[5 * 33]); o.w = pk2(s[6 * 33], s[7 * 33]);
        *(GAS v4u*)(t.WT + (size_t)(t.roff + t.n0 + n) * t.K + t.k0 + 8 * c) = o; }
    LDS_WAIT(); asm volatile("" ::: "memory");
}
__device__ __forceinline__ void convert_weights(const float* w_in, const float* w_out, const float* w_up, const float* w_down, int which, unsigned char* ws, LAS unsigned char* lds, int blk, int G) {
    PHASE_IDX();
    LAS float* scr = (LAS float*)(lds + RING_OFF + wave * 16384);
    bf16* WIN = (bf16*)(ws + WS_WIN); bf16* WOUT = (bf16*)(ws + WS_WOUT); bf16* WUP = (bf16*)(ws + WS_WUP); bf16* WDN = (bf16*)(ws + WS_WDN);
    constexpr int I_IN = (DM / 64) * (INCOLS / 32), I_OUT = (DM / 64) * (DM / 32), I_UP = (DM / 64) * (NUP / 32), I_DN = (DFF / 64) * (DM / 32);
    const int lo = (which & 1) ? 0 : I_IN + I_OUT, hi = (which & 2) ? I_IN + I_OUT + I_UP + I_DN : I_IN + I_OUT;
    auto item = [&](int it) -> TrItem {
        TrItem t; int r = it;
        if (r < I_IN) { t.W = w_in; t.WT = WIN; t.K = DM; t.N = INCOLS; }
        else if ((r -= I_IN) < I_OUT) { t.W = w_out; t.WT = WOUT; t.K = DM; t.N = DM; }
        else if ((r -= I_OUT) < I_UP) { t.W = w_up; t.WT = WUP; t.K = DM; t.N = NUP; }
        else { r -= I_UP; t.W = w_down; t.WT = WDN; t.K = DFF; t.N = DM; }
        const int nblk = t.N / 32; t.k0 = 64 * (r / nblk); t.n0 = 32 * (r % nblk);
        t.roff = (t.W == w_in) ? (t.n0 >= NDNR ? NDN - NDNR : 0) : (t.W == w_up) ? ((t.n0 < DFF ? (t.n0 >> 7) * 256 + (t.n0 & 127) : ((t.n0 - DFF) >> 7) * 256 + 128 + ((t.n0 - DFF) & 127)) - t.n0) : 0;
        return t; };
    int it = lo + gw;
    f32x4 v[8], vn[8];
    TrItem cur = item(it < hi ? it : lo);
    if (it < hi) tr_load(cur, v, lane);
    while (it < hi) {
        const int nit = it + NGW; TrItem nxt = cur;
        if (nit < hi) { nxt = item(nit); tr_load(nxt, vn, lane); }
        tr_store(cur, v, scr, lane);
#pragma unroll
        for (int i = 0; i < 8; ++i) v[i] = vn[i];
        cur = nxt; it = nit;
    }
    __syncthreads();
}

__device__ __forceinline__ void norm_row(const float* xrow, const f32x4 (&g)[8], bf16* hrow, int lane) {
    f32x4 v[8]; float ss = 0.f;
#pragma unroll
    for (int j = 0; j < 8; ++j) { v[j] = __builtin_nontemporal_load((const GAS f32x4*)(xrow + 4 * lane + 256 * j)); ss += (v[j].x * v[j].x + v[j].y * v[j].y) + (v[j].z * v[j].z + v[j].w * v[j].w); }
    const float rstd = rsqrtf(wave_sum(ss) * (1.f / DM) + NORM_EPS);
#pragma unroll
    for (int j = 0; j < 8; ++j) { const f32x4 gg = g[j];
        v2u o; o.x = pk2(v[j].x * rstd * gg.x, v[j].y * rstd * gg.y); o.y = pk2(v[j].z * rstd * gg.z, v[j].w * rstd * gg.w);
        *(GAS v2u*)(hrow + 4 * lane + 256 * j) = o; }
}
template <bool XIN_F32, bool XOUT_F32>
__device__ __forceinline__ void norm_res_row(const bf16* srow, const f32x4 (&gp)[8], const void* xin, void* xout, bool has_next, const f32x4 (&gx)[8], bf16* hrow, int lane) {
    f32x4 v[8], xi[8]; float ss = 0.f;
    v4u w[4], xw[4];
#pragma unroll
    for (int j = 0; j < 4; ++j) { w[j] = *(const GAS v4u*)(srow + 8 * lane + 512 * j);
        if constexpr (XIN_F32) { xi[2 * j] = __builtin_nontemporal_load((const GAS f32x4*)((const float*)xin + 8 * lane + 512 * j)); xi[2 * j + 1] = __builtin_nontemporal_load((const GAS f32x4*)((const float*)xin + 8 * lane + 512 * j + 4)); }
        else xw[j] = __builtin_nontemporal_load((const GAS v4u*)((const bf16*)xin + 8 * lane + 512 * j)); }
#pragma unroll
    for (int j = 0; j < 4; ++j) { v[2 * j] = (f32x4){bflo(w[j].x), bfhi(w[j].x), bflo(w[j].y), bfhi(w[j].y)}; v[2 * j + 1] = (f32x4){bflo(w[j].z), bfhi(w[j].z), bflo(w[j].w), bfhi(w[j].w)};
        if constexpr (!XIN_F32) { xi[2 * j] = (f32x4){bflo(xw[j].x), bfhi(xw[j].x), bflo(xw[j].y), bfhi(xw[j].y)}; xi[2 * j + 1] = (f32x4){bflo(xw[j].z), bfhi(xw[j].z), bflo(xw[j].w), bfhi(xw[j].w)}; } }
#pragma unroll
    for (int j = 0; j < 8; ++j) ss += (v[j].x * v[j].x + v[j].y * v[j].y) + (v[j].z * v[j].z + v[j].w * v[j].w);
    const float rstd = rsqrtf(wave_sum(ss) * (1.f / DM) + NORM_EPS);
    if constexpr (XOUT_F32) asm volatile("s_waitcnt vmcnt(0)" ::: "memory");
    float ss2 = 0.f;
#pragma unroll
    for (int j = 0; j < 8; ++j) { v[j] = xi[j] + v[j] * rstd * gp[j]; ss2 += (v[j].x * v[j].x + v[j].y * v[j].y) + (v[j].z * v[j].z + v[j].w * v[j].w); }
#pragma unroll
    for (int j = 0; j < 4; ++j) {
        if constexpr (XOUT_F32) { __builtin_nontemporal_store(v[2 * j], (GAS f32x4*)((float*)xout + 8 * lane + 512 * j)); __builtin_nontemporal_store(v[2 * j + 1], (GAS f32x4*)((float*)xout + 8 * lane + 512 * j + 4)); }
        else { v4u o; o.x = pk2(v[2 * j].x, v[2 * j].y); o.y = pk2(v[2 * j].z, v[2 * j].w); o.z = pk2(v[2 * j + 1].x, v[2 * j + 1].y); o.w = pk2(v[2 * j + 1].z, v[2 * j + 1].w);
            __builtin_nontemporal_store(o, (GAS v4u*)((bf16*)xout + 8 * lane + 512 * j)); } }
    if (has_next) {
        const float rstd2 = rsqrtf(wave_sum(ss2) * (1.f / DM) + NORM_EPS);
#pragma unroll
        for (int j = 0; j < 4; ++j) { const f32x4 g0 = gx[2 * j], g1 = gx[2 * j + 1], a = v[2 * j], c = v[2 * j + 1];
            v4u o; o.x = pk2(a.x * rstd2 * g0.x, a.y * rstd2 * g0.y); o.y = pk2(a.z * rstd2 * g0.z, a.w * rstd2 * g0.w); o.z = pk2(c.x * rstd2 * g1.x, c.y * rstd2 * g1.y); o.w = pk2(c.z * rstd2 * g1.z, c.w * rstd2 * g1.w);
            *(GAS v4u*)(hrow + 8 * lane + 512 * j) = o; }
    }
}

__device__ __forceinline__ void sc_load_cx(const bf16* row, int c0, float (&cx)[16]) {
#pragma unroll
    for (int hf = 0; hf < 2; ++hf) { float cc[8], xx[8]; unpack8(*(const GAS v4u*)(row + 1024 + c0 + 8 * hf), cc); unpack8(*(const GAS v4u*)(row + 2048 + c0 + 8 * hf), xx);
#pragma unroll
        for (int i = 0; i < 8; ++i) cx[8 * hf + i] = cc[i] * xx[i]; }
}
__device__ __forceinline__ void sc_phase(const Str st, const float* conv_sc, const float* sc_norm, int blk, int G) {
    PHASE_IDX();
    const bf16* psc = SPTR(st, bf16, OFF_PSC); bf16* mix = SPTR(st, bf16, OFF_MIX);
    const int c0 = 16 * lane;
    float w0[16], w1[16], w2[16], gn[16];
#pragma unroll
    for (int i = 0; i < 16; ++i) { w0[i] = conv_sc[c0 + i]; w1[i] = conv_sc[1024 + c0 + i]; w2[i] = conv_sc[2048 + c0 + i]; gn[i] = sc_norm[c0 + i]; }
    const int n = st.R / NGW, lr0 = gw * n;
    float cxp[16], cxc[16], cxn[16];
    { int start, len; seq_bounds(st.row0 + lr0, start, len);
      if (st.row0 + lr0 > start) sc_load_cx(psc + (size_t)(lr0 - 1) * NSC, c0, cxp); else {
#pragma unroll
          for (int i = 0; i < 16; ++i) cxp[i] = 0.f; }
      sc_load_cx(psc + (size_t)lr0 * NSC, c0, cxc); }
    v4u ra[4], rb[4], ba[2], bb[2];
#define SC_LOAD_B(dst, lrow) do { const int lq_ = (lrow) < st.R ? (lrow) : st.R - 1; const bf16* rp_ = psc + (size_t)lq_ * NSC + c0; dst[0] = *(const GAS v4u*)(rp_); dst[1] = *(const GAS v4u*)(rp_ + 8); } while (0)
#define SC_LOAD_CX(dst, lrow) do { const int lq_ = (lrow) < st.R ? (lrow) : st.R - 1; const bf16* rp_ = psc + (size_t)lq_ * NSC + c0; \
        dst[0] = *(const GAS v4u*)(rp_ + 1024); dst[1] = *(const GAS v4u*)(rp_ + 1032); dst[2] = *(const GAS v4u*)(rp_ + 2048); dst[3] = *(const GAS v4u*)(rp_ + 2056); } while (0)
#define SC_STEP(k_, BC, BN, RN, RNN) do { \
        const int lr = lr0 + (k_), r = st.row0 + lr; int start, len; seq_bounds(r, start, len); \
        const bool hn = r < start + len - 1; \
        SC_LOAD_B(BN, lr + 1); SC_LOAD_CX(RNN, lr + 2); \
        { float cc[8], xx[8]; unpack8(RN[0], cc); unpack8(RN[2], xx); \
          _Pragma("unroll") for (int i = 0; i < 8; ++i) cxn[i] = cc[i] * xx[i]; \
          unpack8(RN[1], cc); unpack8(RN[3], xx); \
          _Pragma("unroll") for (int i = 0; i < 8; ++i) cxn[8 + i] = cc[i] * xx[i]; } \
        float b[16]; { float t[8]; unpack8(BC[0], t); \
            _Pragma("unroll") for (int i = 0; i < 8; ++i) b[i] = t[i]; \
            unpack8(BC[1], t); \
            _Pragma("unroll") for (int i = 0; i < 8; ++i) b[8 + i] = t[i]; } \
        float y[16]; float ss = 0.f; \
        _Pragma("unroll") for (int i = 0; i < 16; ++i) { const float v = b[i] * (w0[i] * cxp[i] + w1[i] * cxc[i] + w2[i] * (hn ? cxn[i] : 0.f)); y[i] = v; ss += v * v; } \
        ss += __shfl_xor(ss, 1); ss += __shfl_xor(ss, 2); ss += __shfl_xor(ss, 4); \
        const float rstd = rsqrtf(ss * (1.f / 128.f) + NORM_EPS); \
        v4u o0, o1; \
        o0.x = pk2(y[0] * rstd * gn[0], y[1] * rstd * gn[1]); o0.y = pk2(y[2] * rstd * gn[2], y[3] * rstd * gn[3]); o0.z = pk2(y[4] * rstd * gn[4], y[5] * rstd * gn[5]); o0.w = pk2(y[6] * rstd * gn[6], y[7] * rstd * gn[7]); \
        o1.x = pk2(y[8] * rstd * gn[8], y[9] * rstd * gn[9]); o1.y = pk2(y[10] * rstd * gn[10], y[11] * rstd * gn[11]); o1.z = pk2(y[12] * rstd * gn[12], y[13] * rstd * gn[13]); o1.w = pk2(y[14] * rstd * gn[14], y[15] * rstd * gn[15]); \
        bf16* orow = mix + (size_t)lr * DM + 1024 + c0; \
        *(GAS v4u*)(orow) = o0; *(GAS v4u*)(orow + 8) = o1; \
        _Pragma("unroll") for (int i = 0; i < 16; ++i) { cxp[i] = hn ? cxc[i] : 0.f; cxc[i] = cxn[i]; }     \
        } while (0)
    SC_LOAD_B(ba, lr0); SC_LOAD_CX(ra, lr0 + 1);
    for (int k = 0; k < n; k += 2) { SC_STEP(k, ba, bb, ra, rb); SC_STEP(k + 1, bb, ba, rb, ra); }
#undef SC_STEP
#undef SC_LOAD_B
#undef SC_LOAD_CX
}

__device__ __forceinline__ void glu_fixup_phase(const Str st, const float* conv_ffn, int blk, int G) {
    PHASE_IDX();
    const float* SA = SPTR(st, float, OFF_SA); const float* SB = SPTR(st, float, OFF_SB); bf16* hmid = SPTR(st, bf16, OFF_HMID);
    const int NT = st.R / 256; constexpr int PER = DFF / 4;
    for (int it = gtid; it < NT * 2 * PER; it += NGT) {
        const int c4 = (it % PER) * 4, e = (it / PER) & 1, pm = it / (2 * PER);
        const int lr = pm * 256 + (e ? 255 : 0), r = st.row0 + lr; int start, len; seq_bounds(r, start, len);
        f32x4 pv, cv, nv, bv;
        if (e == 0) { cv = *(const GAS f32x4*)(SA + ((size_t)pm * 4 + 0) * DFF + c4); nv = *(const GAS f32x4*)(SA + ((size_t)pm * 4 + 1) * DFF + c4); bv = *(const GAS f32x4*)(SB + ((size_t)pm * 2) * DFF + c4);
            pv = (r > start) ? *(const GAS f32x4*)(SA + ((size_t)(pm - 1) * 4 + 3) * DFF + c4) : (f32x4){0.f, 0.f, 0.f, 0.f}; }
        else { pv = *(const GAS f32x4*)(SA + ((size_t)pm * 4 + 2) * DFF + c4); cv = *(const GAS f32x4*)(SA + ((size_t)pm * 4 + 3) * DFF + c4); bv = *(const GAS f32x4*)(SB + ((size_t)pm * 2 + 1) * DFF + c4);
            nv = (r < start + len - 1) ? *(const GAS f32x4*)(SA + ((size_t)(pm + 1) * 4 + 0) * DFF + c4) : (f32x4){0.f, 0.f, 0.f, 0.f}; }
        const f32x4 k0 = *(const GAS f32x4*)(conv_ffn + c4), k1 = *(const GAS f32x4*)(conv_ffn + DFF + c4), k2 = *(const GAS f32x4*)(conv_ffn + 2 * DFF + c4);
        float o[4];
#pragma unroll
        for (int j = 0; j < 4; ++j) { const float s = k0[j] * pv[j] + k1[j] * cv[j] + k2[j] * nv[j]; o[j] = siluf(s) * bv[j]; }
        v2u w; w.x = cvt2(o[0], o[1]); w.y = cvt2(o[2], o[3]);
        *(GAS v2u*)(hmid + (size_t)lr * DFF + c4) = w;
    }
}

typedef short bf16x8 __attribute__((ext_vector_type(8)));
typedef short s16x4 __attribute__((ext_vector_type(4)));
#define MFMA16(a, b, c) __builtin_amdgcn_mfma_f32_16x16x32_bf16((a), (b), (c), 0, 0, 0)
__device__ __forceinline__ v2u pack4(const f32x4 a) { v2u r; r.x = cvt2(a[0], a[1]); r.y = cvt2(a[2], a[3]); return r; }
__device__ __forceinline__ f32x4 unpack4(const v2u w) { return (f32x4){bflo(w.x), bfhi(w.x), bflo(w.y), bfhi(w.y)}; }
__device__ __forceinline__ bf16x8 pack_pair(const f32x4 a, const f32x4 b) { v4u p; p.x = cvt2(a[0], a[1]); p.y = cvt2(a[2], a[3]); p.z = cvt2(b[0], b[1]); p.w = cvt2(b[2], b[3]); return __builtin_bit_cast(bf16x8, p); }
__device__ __forceinline__ bf16x8 frag_plain(const LAS unsigned char* p) { return *(const LAS bf16x8*)p; }
__device__ __forceinline__ bf16x8 frag_2x8(const LAS unsigned char* p0, const LAS unsigned char* p1) { const v2u a = *(const LAS v2u*)p0, b = *(const LAS v2u*)p1; v4u r; r.x = a.x; r.y = a.y; r.z = b.x; r.w = b.y; return __builtin_bit_cast(bf16x8, r); }
__device__ __forceinline__ bf16x8 frag_tr(const LAS unsigned char* p0, const LAS unsigned char* p1) {
    const s16x4 a = __builtin_amdgcn_ds_read_tr16_b64_v4i16((LAS s16x4*)p0), b = __builtin_amdgcn_ds_read_tr16_b64_v4i16((LAS s16x4*)p1);
    return __builtin_shufflevector(a, b, 0, 1, 2, 3, 4, 5, 6, 7);
}
constexpr int PQB = 272, PXB = 144;
constexpr int TILE_Q = 64 * PQB, TILE_X = 64 * PXB;
constexpr int NUNIT = (TT / 64) * NHEAD;
constexpr size_t CHT = 64 * 128;
constexpr int PL_Q = 0, PL_K = TILE_Q, PL_V = 2 * TILE_Q, PL_MAT = 3 * TILE_Q;
constexpr int PL_GC = PL_MAT + 8 * TILE_X, PL_BE = PL_GC + 512, PL_CW = EXTRA_OFF, PL_END = PL_BE + 512;
static_assert(PL_END <= RING_BYTES, "prep LDS");

struct DeltaBufs { bf16* QN; bf16* KN; bf16* W0; bf16* W1; bf16* UT0; bf16* UT1; bf16* AQ0; bf16* AQ1; float* GC0; float* GC1; };
__device__ __forceinline__ DeltaBufs delta_bufs(const Str s) { return DeltaBufs{SPTR(s, bf16, OFF_QN), SPTR(s, bf16, OFF_KN), SPTR(s, bf16, OFF_W0), SPTR(s, bf16, OFF_W1), SPTR(s, bf16, OFF_UT0), SPTR(s, bf16, OFF_UT1), SPTR(s, bf16, OFF_AQ0), SPTR(s, bf16, OFF_AQ1), SPTR(s, float, OFF_GC0), SPTR(s, float, OFF_GC1)}; }

#define SCHED_FENCE() __builtin_amdgcn_sched_barrier(0)
template <bool DO_R, bool DO_X>
__device__ __forceinline__ void neumann_step(const LAS unsigned char* Rin, const LAS unsigned char* Xin, f32x4 (&accR)[2][2], f32x4 (&accX)[2][2], int jb, int ib, int c, int g, int q, int p) {
    bf16x8 A[2][2], BR[2][2], BX[2][2];
#pragma unroll
    for (int ks = 0; ks < 2; ++ks) {
#pragma unroll
        for (int a = 0; a < 2; ++a) { const LAS unsigned char* y = Xin + (32 * ks + 8 * g + q) * PXB + (32 * jb + 16 * a + 4 * p) * 2; A[ks][a] = frag_tr(y, y + 4 * PXB); }
#pragma unroll
        for (int b = 0; b < 2; ++b) { if (DO_R) BR[ks][b] = frag_plain(Rin + (32 * ib + 16 * b + c) * PXB + (32 * ks + 8 * g) * 2); if (DO_X) BX[ks][b] = frag_plain(Xin + (32 * ib + 16 * b + c) * PXB + (32 * ks + 8 * g) * 2); }
    }
#pragma unroll
    for (int a = 0; a < 2; ++a)
#pragma unroll
        for (int b = 0; b < 2; ++b) { if (DO_R) accR[a][b] = unpack4(*(const LAS v2u*)(Rin + (32 * ib + 16 * b + c) * PXB + (32 * jb + 16 * a + 4 * g) * 2)); accX[a][b] = (f32x4){0.f, 0.f, 0.f, 0.f}; }
    SCHED_FENCE();
#pragma unroll
    for (int ks = 0; ks < 2; ++ks)
#pragma unroll
        for (int a = 0; a < 2; ++a)
#pragma unroll
            for (int b = 0; b < 2; ++b) { if (DO_R) accR[a][b] = MFMA16(A[ks][a], BR[ks][b], accR[a][b]); if (DO_X) accX[a][b] = MFMA16(A[ks][a], BX[ks][b], accX[a][b]); }
    SCHED_FENCE();
}
__device__ __forceinline__ void mat_store(LAS unsigned char* O, const f32x4 (&acc)[2][2], int jb, int ib, int c, int g) {
#pragma unroll
    for (int a = 0; a < 2; ++a)
#pragma unroll
        for (int b = 0; b < 2; ++b) *(LAS v2u*)(O + (32 * ib + 16 * b + c) * PXB + (32 * jb + 16 * a + 4 * g) * 2) = pack4(acc[a][b]);
}

__device__ __forceinline__ void delta_prep(const Str st, const float* conv_qkv, const float* a_log, const float* dt_bias, LAS unsigned char* lds, int blk, int G) {
    PHASE_IDX();
    const bf16* pdn = SPTR(st, bf16, OFF_PDN); const DeltaBufs B = delta_bufs(st); const int row0 = st.row0;
    const int head = blk & 7, dirn = wave >> 2, wq = wave & 3, jb = wq >> 1, ib = wq & 1, c = lane & 15, g = lane >> 4, q = c >> 2, p = lane & 3;
    LAS float* CW = (LAS float*)(lds + PL_CW);
    for (int i = tid; i < 3 * 384; i += NWAVES * 64) { const int tap = i / 384, ch = i % 384; CW[i] = conv_qkv[tap * NQKV + (ch >> 7) * 1024 + head * 128 + (ch & 127)]; }
    LAS float* GCS = (LAS float*)(lds + PL_GC); LAS float* BES = (LAS float*)(lds + PL_BE);
    LAS unsigned char* MAT = lds + PL_MAT + dirn * 4 * TILE_X;
    LAS unsigned char* XA = MAT; LAS unsigned char* XB = MAT + TILE_X; LAS unsigned char* RA = MAT + 2 * TILE_X; LAS unsigned char* RB = MAT + 3 * TILE_X;
    const int gd = (tid >> 6) & 1;
    const float Ae = __expf(a_log[gd * 8 + head]), dtb = dt_bias[gd * 8 + head];
    bf16* Wg = dirn ? B.W1 : B.W0; bf16* UTg = dirn ? B.UT1 : B.UT0; bf16* AQg = dirn ? B.AQ1 : B.AQ0;
    const float SCALE = 0.08838834764831845f;
    const int gstep = G >> 3, gend = st.R / 64;
    constexpr int RPB = 784;
    LAS unsigned char* RAWT = lds + PL_MAT;
    static_assert(66 * RPB <= 8 * TILE_X, "raw tile fits the matrix region");
    v4u raw[7]; unsigned short ga = 0, gb = 0;
#define RAW_LOAD(gch_) do { const int t0_ = (gch_) * 64; int st_, ln_; seq_bounds(row0 + t0_, st_, ln_); st_ -= row0; int ty_ = tid; asm volatile("" : "+v"(ty_)); \
        _Pragma("unroll") for (int k = 0; k < 6; ++k) { const int i = ty_ + 512 * k, row = i / 48, cg = i % 48; \
            raw[k] = *(const GAS v4u*)(pdn + (size_t)(t0_ + row) * NDN + (cg >> 4) * 1024 + head * 128 + (cg & 15) * 8); } \
        if (tid < 96) { const int hr = tid / 48, cg = tid % 48, t = hr ? t0_ + 64 : t0_ - 1; const bool ok = hr ? (t < st_ + ln_) : (t >= st_); \
            raw[6] = ok ? *(const GAS v4u*)(pdn + (size_t)t * NDN + (cg >> 4) * 1024 + head * 128 + (cg & 15) * 8) : (v4u){0u, 0u, 0u, 0u}; } \
        if (tid < 128) { ga = pdn[(size_t)(t0_ + lane) * NDN + 4096 + gd * 8 + head]; gb = pdn[(size_t)(t0_ + lane) * NDN + 4096 + 16 + gd * 8 + head]; } } while (0)
    RAW_LOAD(blk >> 3);
    LDS_BAR();
    for (int gch = blk >> 3; gch < gend; gch += gstep) {
        const int u = gch * 8 + head;
        int tz = tid; asm volatile("" : "+v"(tz));
#pragma unroll
        for (int k = 0; k < 6; ++k) { const int i = tz + 512 * k, row = i / 48, cg = i % 48; *(LAS v4u*)(RAWT + (row + 1) * RPB + cg * 16) = raw[k]; }
        if (tid < 96) { const int hr = tid / 48, cg = tid % 48; *(LAS v4u*)(RAWT + (hr ? 65 : 0) * RPB + cg * 16) = raw[6]; }
        const unsigned short ga_c = ga, gb_c = gb;
        LDS_BAR();
        if (gch + gstep < gend) RAW_LOAD(gch + gstep);
#pragma unroll
        for (int k = 0; k < 6; ++k) {
            const int i = tz + 512 * k, row = i / 48, cg = i % 48, tensor = cg >> 4, c8 = (cg & 15) * 8;
            float xm[8], x0[8], xp[8];
            unpack8(*(const LAS v4u*)(RAWT + row * RPB + cg * 16), xm); unpack8(*(const LAS v4u*)(RAWT + (row + 1) * RPB + cg * 16), x0); unpack8(*(const LAS v4u*)(RAWT + (row + 2) * RPB + cg * 16), xp);
            float s[8]; float ss = 0.f;
            const LAS float* cw = CW + tensor * 128 + c8;
#pragma unroll
            for (int e = 0; e < 8; ++e) { const float v = cw[e] * xm[e] + cw[384 + e] * x0[e] + cw[768 + e] * xp[e]; s[e] = siluf(v); ss += s[e] * s[e]; }
            ss += __shfl_xor(ss, 1); ss += __shfl_xor(ss, 2); ss += __shfl_xor(ss, 4); ss += __shfl_xor(ss, 8);
            const float rn = tensor < 2 ? rsqrtf(ss + L2_EPS) : 1.f;
            v4u o; o.x = cvt2(s[0] * rn, s[1] * rn); o.y = cvt2(s[2] * rn, s[3] * rn); o.z = cvt2(s[4] * rn, s[5] * rn); o.w = cvt2(s[6] * rn, s[7] * rn);
            *(LAS v4u*)(lds + tensor * TILE_Q + row * PQB + c8 * 2) = o;
            if (tensor == 0) *(GAS v4u*)(B.QN + (size_t)u * CHT + row * 128 + c8) = o;
            if (tensor == 1) *(GAS v4u*)(B.KN + (size_t)u * CHT + row * 128 + c8) = o;
        }
        if (tid < 128) {
            const float a = bf1(ga_c), b = bf1(gb_c);
            const float xx = a + dtb, sp = xx > 20.f ? xx : log1pf(__expf(xx));
            float x = -Ae * sp;
#pragma unroll
            for (int o = 1; o < 64; o <<= 1) { const float up = __shfl_up(x, o), dn = __shfl_down(x, o); if (gd == 0) { if (lane >= o) x += up; } else { if (lane + o < 64) x += dn; } }
            GCS[gd * 64 + lane] = x; BES[gd * 64 + lane] = __builtin_amdgcn_rcpf(1.f + __expf(-b));
            const float gtot = __shfl(x, gd ? 0 : 63);
            float* gcp = (gd ? B.GC1 : B.GC0) + (size_t)u * 192;
            gcp[lane] = 0.08838834764831845f * __expf(x); gcp[64 + lane] = __expf(gtot - x); if (lane == 0) gcp[128] = __expf(gtot);
        }
        LDS_BAR();
        {
            f32x4 kk[2][2], kq[2][2];
#pragma unroll
            for (int a = 0; a < 2; ++a)
#pragma unroll
                for (int b = 0; b < 2; ++b) { kk[a][b] = (f32x4){0.f, 0.f, 0.f, 0.f}; kq[a][b] = (f32x4){0.f, 0.f, 0.f, 0.f}; }
#pragma unroll
            for (int kh = 0; kh < 2; ++kh) {
                bf16x8 A[2][2], Bk[2][2], Bq[2][2];
#pragma unroll
                for (int k2 = 0; k2 < 2; ++k2) { const int ks = 2 * kh + k2;
#pragma unroll
                    for (int a = 0; a < 2; ++a) A[k2][a] = frag_plain(lds + PL_K + (32 * jb + 16 * a + c) * PQB + (32 * ks + 8 * g) * 2);
#pragma unroll
                    for (int b = 0; b < 2; ++b) { Bk[k2][b] = frag_plain(lds + PL_K + (32 * ib + 16 * b + c) * PQB + (32 * ks + 8 * g) * 2); Bq[k2][b] = frag_plain(lds + PL_Q + (32 * ib + 16 * b + c) * PQB + (32 * ks + 8 * g) * 2); }
                }
                SCHED_FENCE();
#pragma unroll
                for (int k2 = 0; k2 < 2; ++k2)
#pragma unroll
                    for (int a = 0; a < 2; ++a)
#pragma unroll
                        for (int b = 0; b < 2; ++b) { kk[a][b] = MFMA16(A[k2][a], Bk[k2][b], kk[a][b]); kq[a][b] = MFMA16(A[k2][a], Bq[k2][b], kq[a][b]); }
                SCHED_FENCE();
            }
#pragma unroll
            for (int b = 0; b < 2; ++b) {
                const int i = 32 * ib + 16 * b + c; const float gci = GCS[dirn * 64 + i], bei = BES[dirn * 64 + i];
                v2u aqp[2];
#pragma unroll
                for (int a = 0; a < 2; ++a) {
                    const int j0 = 32 * jb + 16 * a + 4 * g; const f32x4 gcj = *(const LAS f32x4*)(GCS + dirn * 64 + j0);
                    f32x4 x1, r0, aq;
#pragma unroll
                    for (int r = 0; r < 4; ++r) { const int j = j0 + r; const bool strict = dirn ? (i < j) : (i > j), incl = strict || (i == j);
                        const float dec = incl ? __expf(gci - gcj[r]) : 0.f; const float av = strict ? bei * kk[a][b][r] * dec : 0.f;
                        x1[r] = -av; r0[r] = (i == j) ? 1.f : -av; aq[r] = kq[a][b][r] * SCALE * dec; }
                    *(LAS v2u*)(XA + i * PXB + j0 * 2) = pack4(x1); *(LAS v2u*)(RA + i * PXB + j0 * 2) = pack4(r0);
                    aqp[a] = pack4(aq);
                }
                *(GAS v4u*)(AQg + (size_t)u * 4096 + i * 64 + 32 * jb + 8 * g) = (v4u){aqp[0].x, aqp[0].y, aqp[1].x, aqp[1].y};
            }
        }
        LDS_BAR();
        f32x4 acc[2][2], acc2[2][2];
        neumann_step<false, true>(RA, XA, acc, acc2, jb, ib, c, g, q, p); mat_store(XB, acc2, jb, ib, c, g);
        LDS_BAR();
        neumann_step<true, true>(RA, XB, acc, acc2, jb, ib, c, g, q, p); mat_store(RB, acc, jb, ib, c, g); mat_store(XA, acc2, jb, ib, c, g);
        LDS_BAR();
        neumann_step<true, true>(RB, XA, acc, acc2, jb, ib, c, g, q, p); mat_store(RA, acc, jb, ib, c, g); mat_store(XB, acc2, jb, ib, c, g);
        LDS_BAR();
        neumann_step<true, true>(RA, XB, acc, acc2, jb, ib, c, g, q, p); mat_store(RB, acc, jb, ib, c, g); mat_store(XA, acc2, jb, ib, c, g);
        LDS_BAR();
        neumann_step<true, true>(RB, XA, acc, acc2, jb, ib, c, g, q, p); mat_store(RA, acc, jb, ib, c, g); mat_store(XB, acc2, jb, ib, c, g);
        LDS_BAR();
        neumann_step<true, false>(RA, XB, acc, acc2, jb, ib, c, g, q, p);
#pragma unroll
        for (int a = 0; a < 2; ++a) { const int j0 = 32 * jb + 16 * a + 4 * g; const f32x4 gcj = *(const LAS f32x4*)(GCS + dirn * 64 + j0), bej = *(const LAS f32x4*)(BES + dirn * 64 + j0);
#pragma unroll
            for (int b = 0; b < 2; ++b) { f32x4 t1, t2;
#pragma unroll
                for (int r = 0; r < 4; ++r) { t1[r] = acc[a][b][r] * bej[r]; t2[r] = t1[r] * __expf(gcj[r]); }
                acc[a][b] = t1; acc2[a][b] = t2; } }
        mat_store(RB, acc, jb, ib, c, g); mat_store(XA, acc2, jb, ib, c, g);
        LDS_BAR();
        {
            bf16x8 At[4][2], Bv[2][2];
#pragma unroll
            for (int a = 0; a < 4; ++a)
#pragma unroll
                for (int ks = 0; ks < 2; ++ks) At[a][ks] = frag_plain(RB + (16 * a + c) * PXB + (32 * ks + 8 * g) * 2);
#pragma unroll
            for (int et = 0; et < 2; ++et)
#pragma unroll
                for (int ks = 0; ks < 2; ++ks) { const LAS unsigned char* v = lds + PL_V + (32 * ks + 8 * g + q) * PQB + (32 * wq + 16 * et + 4 * p) * 2; Bv[et][ks] = frag_tr(v, v + 4 * PQB); }
            SCHED_FENCE();
            f32x4 o[2][4];
#pragma unroll
            for (int et = 0; et < 2; ++et)
#pragma unroll
                for (int a = 0; a < 4; ++a) { o[et][a] = (f32x4){0.f, 0.f, 0.f, 0.f};
#pragma unroll
                    for (int ks = 0; ks < 2; ++ks) o[et][a] = MFMA16(At[a][ks], Bv[et][ks], o[et][a]); }
            SCHED_FENCE();
#pragma unroll
            for (int et = 0; et < 2; ++et)
#pragma unroll
                for (int s = 0; s < 2; ++s) { const v2u lo = pack4(o[et][2 * s]), hi = pack4(o[et][2 * s + 1]);
                    *(GAS v4u*)(UTg + (size_t)u * CHT + (32 * wq + 16 * et + c) * 64 + 32 * s + 8 * g) = (v4u){lo.x, lo.y, hi.x, hi.y}; }
        }
        {
            bf16x8 Ak[2][2], Bt[4][2];
#pragma unroll
            for (int dt = 0; dt < 2; ++dt)
#pragma unroll
                for (int ks = 0; ks < 2; ++ks) { const LAS unsigned char* kp = lds + PL_K + (32 * ks + 8 * g + q) * PQB + (32 * wq + 16 * dt + 4 * p) * 2; Ak[dt][ks] = frag_tr(kp, kp + 4 * PQB); }
#pragma unroll
            for (int b = 0; b < 4; ++b)
#pragma unroll
                for (int ks = 0; ks < 2; ++ks) Bt[b][ks] = frag_plain(XA + (16 * b + c) * PXB + (32 * ks + 8 * g) * 2);
            SCHED_FENCE();
            f32x4 o[2][4];
#pragma unroll
            for (int dt = 0; dt < 2; ++dt)
#pragma unroll
                for (int b = 0; b < 4; ++b) { o[dt][b] = (f32x4){0.f, 0.f, 0.f, 0.f};
#pragma unroll
                    for (int ks = 0; ks < 2; ++ks) o[dt][b] = MFMA16(Ak[dt][ks], Bt[b][ks], o[dt][b]); }
            SCHED_FENCE();
#pragma unroll
            for (int b = 0; b < 4; ++b) { const v2u lo = pack4(o[0][b]), hi = pack4(o[1][b]);
                *(GAS v4u*)(Wg + (size_t)u * CHT + (16 * b + c) * 128 + 32 * wq + 8 * g) = (v4u){lo.x, lo.y, hi.x, hi.y}; }
        }
        LDS_BAR();
    }
#undef RAW_LOAD
}

constexpr int SQB = 272, SKB = 288, SAB = 160, SUB = 144;
constexpr int SL_W = 0, SL_Q = 64 * SQB, SL_K = 2 * 64 * SQB, SL_A = SL_K + 64 * SKB, SL_G = SL_A + 64 * SAB, SL_U = SL_G + 768, SL_BUF = SL_U + 64 * SUB;
static_assert(2 * SL_BUF <= RING_BYTES, "scan LDS");
constexpr int NLD = 19;
__device__ __forceinline__ void delta_scan(const Str st, LAS unsigned char* lds, int blk, int G) {
    if (blk < 0 || blk >= 64) return;
    PHASE_IDX();
    const DeltaBufs B = delta_bufs(st);
    const int sid = (blk & 7) | ((blk >> 4) << 3), half = (blk >> 3) & 1, seq = sid >> 4, dirn = (sid >> 3) & 1, head = sid & 7;
    const int len = st.R >> 1, start = seq * len, NC = len / 64, gch0 = start / 64;
    const bf16* Wg = dirn ? B.W1 : B.W0; bf16* UTg = dirn ? B.UT1 : B.UT0; const bf16* AQg = dirn ? B.AQ1 : B.AQ0; const float* GCg = dirn ? B.GC1 : B.GC0;
    const float SCALE = 0.08838834764831845f;
#define UNIT_OF(ci) ((size_t)((gch0 + (dirn ? NC - 1 - (ci) : (ci))) * 8 + head))
    if (wave >= 4) {
#define GLD(dst, base, voff, imm) asm volatile("s_nop 4\n\tglobal_load_dwordx4 %0, %1, %2 offset:" #imm : "=v"(dst) : "v"(voff), "s"(base) : "memory")
        const int lu = tid & 127;
#define PIECE_WQK(k_, h_) const int x = 512 * (h_) + lu + 128 * (k_), row = x >> 4, cc = x & 15
#define PIECE_A(k_, h_)   const int x = 256 * (h_) + lu + 128 * (k_), row = x >> 3, cc = x & 7
#define WR_WQK(b_, k_, h_, RW, RQ, RK) do { PIECE_WQK(k_, h_); *(LAS v4u*)(b_ + SL_W + row * SQB + cc * 16) = RW; *(LAS v4u*)(b_ + SL_K + row * SKB + cc * 16) = RK; \
            const int pb2 = ((cc & 12) * 8 + 16 * (cc & 1) + 4 * ((cc >> 1) & 1)) * 2; *(LAS v2u*)(b_ + SL_Q + row * SQB + pb2) = (v2u){RQ.x, RQ.y}; *(LAS v2u*)(b_ + SL_Q + row * SQB + pb2 + 16) = (v2u){RQ.z, RQ.w}; } while (0)
        if (wave >= 6) {
            const int oh = half ^ 1;
            const unsigned vo = (unsigned)lu * 16u + 4096u + 8192u * (unsigned)oh, voa = (unsigned)lu * 16u + 4096u + 4096u * (unsigned)oh;
            v4u R[14];
#define LO_ISSUE(ci) do { const size_t u_ = UNIT_OF(ci); const bf16* pw_ = Wg + u_ * CHT; const bf16* pq_ = B.QN + u_ * CHT; const bf16* pk_ = B.KN + u_ * CHT; const bf16* pa_ = AQg + u_ * 4096; \
                GLD(R[0], pw_, vo, -4096); GLD(R[4], pq_, vo, -4096); GLD(R[8], pk_, vo, -4096); GLD(R[1], pw_, vo, -2048); GLD(R[5], pq_, vo, -2048); GLD(R[9], pk_, vo, -2048); \
                GLD(R[2], pw_, vo, 0); GLD(R[6], pq_, vo, 0); GLD(R[10], pk_, vo, 0); GLD(R[3], pw_, vo, 2048); GLD(R[7], pq_, vo, 2048); GLD(R[11], pk_, vo, 2048); \
                GLD(R[12], pa_, voa, -4096); GLD(R[13], pa_, voa, -2048); } while (0)
#define LO_WAIT0() asm volatile("s_waitcnt vmcnt(0)" : "+v"(R[0]), "+v"(R[1]), "+v"(R[2]), "+v"(R[3]), "+v"(R[4]), "+v"(R[5]), "+v"(R[6]), "+v"(R[7]), "+v"(R[8]), "+v"(R[9]), "+v"(R[10]), "+v"(R[11]), "+v"(R[12]), "+v"(R[13]) :: "memory")
#define LO_WRITE(buf) do { LAS unsigned char* b_ = lds + (buf) * SL_BUF; \
                _Pragma("unroll") for (int k = 0; k < 4; ++k) WR_WQK(b_, k, oh, R[k], R[4 + k], R[8 + k]); \
                _Pragma("unroll") for (int k = 0; k < 2; ++k) { PIECE_A(k, oh); *(LAS v4u*)(b_ + SL_A + row * SAB + cc * 16) = R[12 + k]; } } while (0)
            LO_ISSUE(0); LO_WAIT0(); LO_WRITE(0);
            LDS_BAR();
            for (int ci = 0; ci < NC; ci += 2) {
                { const int cn = ci + 1 < NC ? ci + 1 : NC - 1; LO_ISSUE(cn); } LO_WAIT0(); LO_WRITE(1);
                LDS_BAR();
                { const int cn = ci + 2 < NC ? ci + 2 : NC - 1; LO_ISSUE(cn); } LO_WAIT0(); LO_WRITE(0);
                LDS_BAR();
            }
#undef LO_ISSUE
#undef LO_WAIT0
#undef LO_WRITE
        } else {
            const unsigned vo = (unsigned)lu * 16u + 4096u + 8192u * (unsigned)half, voa = (unsigned)lu * 16u + 4096u + 4096u * (unsigned)half, vou = (unsigned)lu * 16u + 4096u, vog = (unsigned)(lu < 48 ? lu : 47) * 16u;
            constexpr int NOWN = 19;
            v4u RA[NOWN], RB[NOWN];
#define LW_ISSUE(ci, R) do { const size_t u_ = UNIT_OF(ci); const bf16* pw_ = Wg + u_ * CHT; const bf16* pq_ = B.QN + u_ * CHT; const bf16* pk_ = B.KN + u_ * CHT; \
                const bf16* pa_ = AQg + u_ * 4096; const bf16* pu_ = UTg + u_ * CHT + half * 4096; const float* pg_ = GCg + u_ * 192; \
                GLD(R[0], pw_, vo, -4096); GLD(R[4], pq_, vo, -4096); GLD(R[8], pk_, vo, -4096); GLD(R[1], pw_, vo, -2048); GLD(R[5], pq_, vo, -2048); GLD(R[9], pk_, vo, -2048); \
                GLD(R[2], pw_, vo, 0); GLD(R[6], pq_, vo, 0); GLD(R[10], pk_, vo, 0); GLD(R[3], pw_, vo, 2048); GLD(R[7], pq_, vo, 2048); GLD(R[11], pk_, vo, 2048); \
                GLD(R[12], pa_, voa, -4096); GLD(R[13], pa_, voa, -2048); \
                GLD(R[14], pu_, vou, -4096); GLD(R[15], pu_, vou, -2048); GLD(R[16], pu_, vou, 0); GLD(R[17], pu_, vou, 2048); \
                GLD(R[18], pg_, vog, 0); } while (0)
#define LW_WAIT(N, R) asm volatile("s_waitcnt vmcnt(" #N ")" : "+v"(R[0]), "+v"(R[1]), "+v"(R[2]), "+v"(R[3]), "+v"(R[4]), "+v"(R[5]), "+v"(R[6]), "+v"(R[7]), "+v"(R[8]), \
                "+v"(R[9]), "+v"(R[10]), "+v"(R[11]), "+v"(R[12]), "+v"(R[13]), "+v"(R[14]), "+v"(R[15]), "+v"(R[16]), "+v"(R[17]), "+v"(R[18]) :: "memory")
#define LW_WRITE(buf, R) do { LAS unsigned char* b_ = lds + (buf) * SL_BUF; \
                _Pragma("unroll") for (int k = 0; k < 4; ++k) WR_WQK(b_, k, half, R[k], R[4 + k], R[8 + k]); \
                _Pragma("unroll") for (int k = 0; k < 2; ++k) { PIECE_A(k, half); *(LAS v4u*)(b_ + SL_A + row * SAB + cc * 16) = R[12 + k]; } \
                _Pragma("unroll") for (int k = 0; k < 4; ++k) { const int x = lu + 128 * k, row = x >> 3, cc = x & 7; *(LAS v4u*)(b_ + SL_U + row * SUB + cc * 16) = R[14 + k]; } \
                if (lu < 48) *(LAS v4u*)(b_ + SL_G + lu * 16) = R[18]; } while (0)
            LW_ISSUE(0, RA); LW_WAIT(0, RA); LW_WRITE(0, RA);
            LW_ISSUE(1, RA); LW_ISSUE(2, RB);
            LDS_BAR();
            for (int ci = 0; ci < NC; ci += 2) {
                LW_WAIT(19, RA);
                LW_WRITE(1, RA); { const int cn = ci + 3 < NC ? ci + 3 : NC - 1; LW_ISSUE(cn, RA); }
                LDS_BAR();
                LW_WAIT(19, RB);
                LW_WRITE(0, RB); { const int cn = ci + 4 < NC ? ci + 4 : NC - 1; LW_ISSUE(cn, RB); }
                LDS_BAR();
            }
            asm volatile("s_waitcnt vmcnt(0)" ::: "memory");
#undef LW_ISSUE
#undef LW_WAIT
#undef LW_WRITE
        }
#undef GLD
#undef PIECE_WQK
#undef PIECE_A
#undef WR_WQK
    } else {
        const int c = lane & 15, g = lane >> 4, q = c >> 2, p = lane & 3, e0 = 64 * half + 16 * wave;
        f32x4 S[8];
#pragma unroll
        for (int i = 0; i < 8; ++i) S[i] = (f32x4){0.f, 0.f, 0.f, 0.f};
        const int offA = c * SQB + 16 * g, offX = c * SAB + 16 * g, offT = (4 * g + q) * SKB + 8 * p;
#define LDWQ(ks, AW, AQ) do { _Pragma("unroll") for (int a = 0; a < 4; ++a) { AW[a] = frag_plain(b_ + SL_W + offA + a * 16 * SQB + (ks) * 64); AQ[a] = frag_plain(b_ + SL_Q + offA + a * 16 * SQB + (ks) * 64); } } while (0)
#define MMWQ(ks, AW, AQ) do { _Pragma("unroll") for (int a = 0; a < 4; ++a) { vw[a] = MFMA16(AW[a], Sb[ks], vw[a]); qs[a] = MFMA16(AQ[a], Sb[ks], qs[a]); } } while (0)
#define LDKN(dt0, AK) do { _Pragma("unroll") for (int d = 0; d < 4; ++d) _Pragma("unroll") for (int ks = 0; ks < 2; ++ks) { const LAS unsigned char* kp = b_ + SL_K + offT + ks * 32 * SKB + ((dt0) + d) * 32; AK[d][ks] = frag_tr(kp, kp + 16 * SKB); } } while (0)
#define MMKN(dt0, AK) do { _Pragma("unroll") for (int d = 0; d < 4; ++d) { S[(dt0) + d] = S[(dt0) + d] * gl; _Pragma("unroll") for (int ks = 0; ks < 2; ++ks) S[(dt0) + d] = MFMA16(AK[d][ks], Vd[ks], S[(dt0) + d]); } } while (0)
        LDS_BAR();
        for (int ci = 0; ci < NC; ++ci) {
            const size_t u = UNIT_OF(ci);
            const LAS unsigned char* b_ = lds + (ci & 1) * SL_BUF;
            bf16x8 Aw0[4], Aq0[4], Aw1[4], Aq1[4];
            LDWQ(0, Aw0, Aq0);
            bf16x8 Sb[4];
#pragma unroll
            for (int ks = 0; ks < 4; ++ks) Sb[ks] = pack_pair(S[2 * ks], S[2 * ks + 1]);
            f32x4 vw[4], qs[4];
#pragma unroll
            for (int a = 0; a < 4; ++a) { vw[a] = (f32x4){0.f, 0.f, 0.f, 0.f}; qs[a] = (f32x4){0.f, 0.f, 0.f, 0.f}; }
            LDWQ(1, Aw1, Aq1); SCHED_FENCE();
            MMWQ(0, Aw0, Aq0); SCHED_FENCE();
            LDWQ(2, Aw0, Aq0); SCHED_FENCE();
            MMWQ(1, Aw1, Aq1); SCHED_FENCE();
            LDWQ(3, Aw1, Aq1); SCHED_FENCE();
            MMWQ(2, Aw0, Aq0); SCHED_FENCE();
            bf16x8 Aa[4][2], Ak[4][2];
#pragma unroll
            for (int a = 0; a < 4; ++a)
#pragma unroll
                for (int ks = 0; ks < 2; ++ks) Aa[a][ks] = frag_plain(b_ + SL_A + offX + a * 16 * SAB + ks * 64);
            const LAS float* GCb = (const LAS float*)(b_ + SL_G);
            const float gl = GCb[128];
            f32x4 eq4[4], ed4[4]; v2u uc[4];
#pragma unroll
            for (int a = 0; a < 4; ++a) { eq4[a] = *(const LAS f32x4*)(GCb + 16 * a + 4 * g); ed4[a] = *(const LAS f32x4*)(GCb + 64 + 16 * a + 4 * g); uc[a] = *(const LAS v2u*)(b_ + SL_U + (16 * wave + c) * SUB + (32 * (a >> 1) + 8 * g + 4 * (a & 1)) * 2); }
            SCHED_FENCE();
            MMWQ(3, Aw1, Aq1); SCHED_FENCE();
            LDKN(0, Ak); SCHED_FENCE();
            f32x4 vn[4], vd[4];
#pragma unroll
            for (int a = 0; a < 4; ++a) { const f32x4 uu = unpack4(uc[a]);
#pragma unroll
                for (int r = 0; r < 4; ++r) { vn[a][r] = uu[r] - vw[a][r]; vd[a][r] = vn[a][r] * ed4[a][r]; qs[a][r] *= eq4[a][r]; } }
            bf16x8 Vb[2], Vd[2];
#pragma unroll
            for (int ks = 0; ks < 2; ++ks) { Vb[ks] = pack_pair(vn[2 * ks], vn[2 * ks + 1]); Vd[ks] = pack_pair(vd[2 * ks], vd[2 * ks + 1]); }
            SCHED_FENCE();
            MMKN(0, Ak); SCHED_FENCE();
            LDKN(4, Ak); SCHED_FENCE();
#pragma unroll
            for (int a = 0; a < 4; ++a) {
#pragma unroll
                for (int ks = 0; ks < 2; ++ks) qs[a] = MFMA16(Aa[a][ks], Vb[ks], qs[a]);
            }
            SCHED_FENCE();
            MMKN(4, Ak); SCHED_FENCE();
#pragma unroll
            for (int s = 0; s < 2; ++s) { const v2u lo = pack4(qs[2 * s]), hi = pack4(qs[2 * s + 1]); *(GAS v4u*)(UTg + u * CHT + (e0 + c) * 64 + 32 * s + 8 * g) = (v4u){lo.x, lo.y, hi.x, hi.y}; }
            LDS_BAR();
        }
#undef LDWQ
#undef MMWQ
#undef LDKN
#undef MMKN
    }
#undef UNIT_OF
}

__device__ __forceinline__ void combine_fast(const Str st, const float* dn_norm, LAS unsigned char* lds, int blk, int G) {
    PHASE_IDX();
    const DeltaBufs B = delta_bufs(st); const bf16* pdn = SPTR(st, bf16, OFF_PDN); bf16* mix = SPTR(st, bf16, OFF_MIX); const int nunit = (st.R / 64) * NHEAD;
    LAS unsigned char* T = lds + wave * 16384;
    LAS float* RS = (LAS float*)(lds + EXTRA_OFF + wave * 256);
    const int ck = lane & 15;
    float gn[8];
#pragma unroll
    for (int i = 0; i < 8; ++i) gn[i] = dn_norm[ck * 8 + i];
    for (int u = gw; u < nunit; u += NGW) {
        const int gch = u >> 3, head = u & 7;
        const bf16* f = B.UT0 + (size_t)u * CHT; const bf16* b = B.UT1 + (size_t)u * CHT;
        float ssa[8];
#pragma unroll
        for (int i = 0; i < 8; ++i) ssa[i] = 0.f;
        const int t8 = (lane & 7) * 8;
#pragma unroll 4
        for (int it = 0; it < 16; ++it) {
            const int e = it * 8 + (lane >> 3);
            float of[8], ob[8]; unpack8(*(const GAS v4u*)(f + e * 64 + t8), of); unpack8(*(const GAS v4u*)(b + e * 64 + t8), ob);
#pragma unroll
            for (int i = 0; i < 8; ++i) { const float o = of[i] + ob[i]; ssa[i] += o * o; const int tok = (t8 & 32) + 16 * (i >> 2) + ((t8 >> 1) & 12) + (i & 3);
                *(LAS unsigned short*)(T + tok * 256 + ((it ^ (tok & 15)) << 4) + (lane >> 3) * 2) = (unsigned short)(cvt2(o, 0.f) & 0xffffu); }
        }
#pragma unroll
        for (int i = 0; i < 8; ++i) { ssa[i] += __shfl_xor(ssa[i], 8); ssa[i] += __shfl_xor(ssa[i], 16); ssa[i] += __shfl_xor(ssa[i], 32); }
        if (lane < 8) {
#pragma unroll
            for (int i = 0; i < 8; ++i) RS[(t8 & 32) + 16 * (i >> 2) + ((t8 >> 1) & 12) + (i & 3)] = rsqrtf(ssa[i] * (1.f / 128.f) + NORM_EPS); }
        LDS_WAIT();
        v4u zq[4];
#pragma unroll
        for (int rr = 0; rr < 16; ++rr) {
            const int tok = 4 * rr + (lane >> 4); const size_t row = (size_t)gch * 64 + tok;
            if ((rr & 3) == 0) {
#pragma unroll
                for (int q4 = 0; q4 < 4; ++q4) zq[q4] = *(const GAS v4u*)(pdn + ((size_t)gch * 64 + 4 * (rr + q4) + (lane >> 4)) * NDN + 3072 + head * 128 + ck * 8); }
            float o[8], z[8]; unpack8(*(const LAS v4u*)(T + tok * 256 + ((ck ^ (tok & 15)) << 4)), o);
            unpack8(zq[rr & 3], z);
            const float rstd = RS[tok];
            float y[8];
#pragma unroll
            for (int i = 0; i < 8; ++i) y[i] = o[i] * rstd * gn[i] * siluf(z[i]);
            v4u w; w.x = cvt2(y[0], y[1]); w.y = cvt2(y[2], y[3]); w.z = cvt2(y[4], y[5]); w.w = cvt2(y[6], y[7]);
            *(GAS v4u*)(mix + row * DM + head * 128 + ck * 8) = w;
        }
        LDS_WAIT();
    }
}

struct Args { const float* in[17]; float* out; unsigned char* ws; };
__device__ __forceinline__ void norm0_phase(const Str st, const float* g, int blk, int G) {
    PHASE_IDX();
    bf16* H = SPTR(st, bf16, OFF_H);
    f32x4 gg[8];
#pragma unroll
    for (int j = 0; j < 8; ++j) gg[j] = *(const GAS f32x4*)(g + 4 * lane + 256 * j);
    for (int m = gw; m < st.R; m += NGW) norm_row(st.xin + (size_t)m * DM, gg, H + (size_t)m * DM, lane);
}
template <int MODE>
__device__ __forceinline__ void normres_phase(const Str st, size_t src_off, const float* gpost, float* out, const float* gnext, int blk, int G) {
    PHASE_IDX();
    const bf16* src = SPTR(st, bf16, src_off); bf16* H = SPTR(st, bf16, OFF_H); float* xout = out + (size_t)st.row0 * DM;
    f32x4 gp[8], gx[8];
#pragma unroll
    for (int j = 0; j < 8; ++j) { const int e = 8 * lane + 512 * (j >> 1) + 4 * (j & 1); gp[j] = *(const GAS f32x4*)(gpost + e); gx[j] = MODE != 2 ? *(const GAS f32x4*)(gnext + e) : (f32x4){0.f, 0.f, 0.f, 0.f}; }
    for (int m = gw; m < st.R; m += NGW) {
        float* slot = xout + (size_t)m * DM;
        if constexpr (MODE == 1) norm_res_row<true, false>(src + (size_t)m * DM, gp, st.xin + (size_t)m * DM, slot, MODE != 2, gx, H + (size_t)m * DM, lane);
        else if constexpr (MODE == 2) norm_res_row<false, true>(src + (size_t)m * DM, gp, slot, slot, MODE != 2, gx, H + (size_t)m * DM, lane);
        else norm_res_row<false, false>(src + (size_t)m * DM, gp, slot, slot, MODE != 2, gx, H + (size_t)m * DM, lane);
    }
}
__global__ void __launch_bounds__(NWAVES * 64, 2) enc_fwd(Args args) {
    extern __shared__ __attribute__((aligned(16))) unsigned char lds_raw[];
    LAS unsigned char* lds = (LAS unsigned char*)lds_raw;
    volatile LAS unsigned* MISC = (volatile LAS unsigned*)(lds + MISC_OFF);
    const int G = gridDim.x, blk = blockIdx.x;
    unsigned char* ws = args.ws;
    gu32* ctl = (gu32*)(ws + WS_CTL);
    for (int u = threadIdx.x; u < (LDS_BYTES - LDSCTL_OFF) / 4; u += NWAVES * 64) ((LAS unsigned*)(lds + LDSCTL_OFF))[u] = 0u;
    __syncthreads();
    XcdBarrier bar = xcd_barrier_post((unsigned*)(ctl + CW_BAR), MISC + 8);
#define GRID_BAR() xcd_barrier(bar)
#define WSP(T, off) ((T*)(ws + (off)))
    const Str SP{0, TP, ws + WS_ARENA_P, args.in[0]}, SS{TP, TSM, ws + WS_ARENA_S, args.in[1]};

#define PHASE_IN_R(st, L0_, L1_, Gs_, cs_)    do { pg8::Gemm g{SPTR(st, bf16, OFF_H), WSP(bf16, WS_WIN), (st).R, NIN, DM}; pg8::RangeOrder S; S.init((st).R, NIN, G, blk); S.wgm = WGM_IN; S.L0 = (L0_); S.L1 = (L1_); S.Gs = (Gs_); S.cs = (cs_); \
          pg8::EpiBf16R E{SPTR(st, bf16, OFF_PDN), NDN, NDN / 256, SPTR(st, bf16, OFF_PSC), NSC}; \
          pg8::gemm_phase<pg8::EpiBf16R, pg8::RangeOrder, PG8_ALIGN, PG8_SP2>(lds + RING_OFF, g, S, E); } while (0)
#define PHASE_IN(st)    PHASE_IN_R(st, 0, ((st).R / 256) * (NIN / 256), G, blk)
#define PHASE_OUT(st)   do { pg8::Gemm g{SPTR(st, bf16, OFF_MIX), WSP(bf16, WS_WOUT), (st).R, DM, DM}; pg8::StaticOrder S; S.init((st).R, DM, G, blk); \
          pg8::EpiBf16R E{SPTR(st, bf16, OFF_M), DM, 1 << 20, SPTR(st, bf16, OFF_M), DM}; \
          pg8::gemm_phase<pg8::EpiBf16R, pg8::StaticOrder, PG8_ALIGN, PG8_SP2>(lds + RING_OFF, g, S, E); } while (0)
#define PHASE_UP(st, l, L0_, L1_, Gs_, cs_)   do { pg8::Gemm g{SPTR(st, bf16, OFF_H), WSP(bf16, WS_WUP), (st).R, NUP, DM}; pg8::RangeOrder S; S.init((st).R, NUP, G, blk); S.wgm = WGM_UP; S.L0 = (L0_); S.L1 = (L1_); S.Gs = (Gs_); S.cs = (cs_); \
          pg8::EpiGlu E{SPTR(st, bf16, OFF_HMID), args.in[14] + (size_t)(l) * 3 * DFF, SPTR(st, float, OFF_SA), SPTR(st, float, OFF_SB), (LAS float*)(lds + EXTRA_OFF), DFF}; \
          pg8::gemm_phase<pg8::EpiGlu, pg8::RangeOrder, true, PG8_SP2>(lds + RING_OFF, g, S, E); } while (0)
#define PHASE_DOWN(st, L0_, L1_, Gs_, cs_)    do { pg8::Gemm g{SPTR(st, bf16, OFF_HMID), WSP(bf16, WS_WDN), (st).R, DM, DFF}; pg8::RangeOrder S; S.init((st).R, DM, G, blk); S.L0 = (L0_); S.L1 = (L1_); S.Gs = (Gs_); S.cs = (cs_); \
          pg8::EpiBf16R E{SPTR(st, bf16, OFF_F), DM, 1 << 20, SPTR(st, bf16, OFF_F), DM}; \
          pg8::gemm_phase<pg8::EpiBf16R, pg8::RangeOrder, PG8_ALIGN, PG8_SP2>(lds + RING_OFF, g, S, E); } while (0)
#define PHASE_SC(st, l)    sc_phase(st, args.in[8] + (size_t)(l) * 3 * 1024, args.in[9] + (size_t)(l) * 1024, blk, G)
#define PHASE_PREP(st, l)  delta_prep(st, args.in[4] + (size_t)(l) * 3 * NQKV, args.in[5] + (l) * 16, args.in[6] + (l) * 16, lds, blk, G)
#define PHASE_COMB(st, l)  combine_fast(st, args.in[7] + (l) * 128, lds, blk, G)
#define PHASE_NB(st, l)    do { if ((l) == 0) normres_phase<1>(st, OFF_M, args.in[11] + (size_t)(l) * DM, args.out, args.in[12] + (size_t)(l) * DM, blk, G); \
                                else normres_phase<0>(st, OFF_M, args.in[11] + (size_t)(l) * DM, args.out, args.in[12] + (size_t)(l) * DM, blk, G); } while (0)
#define PHASE_NC(st, l)    do { if ((l) + 1 < DEPTH) normres_phase<0>(st, OFF_F, args.in[16] + (size_t)(l) * DM, args.out, args.in[2] + (size_t)((l) + 1) * DM, blk, G); \
                                else normres_phase<2>(st, OFF_F, args.in[16] + (size_t)(l) * DM, args.out, nullptr, blk, G); } while (0)
#define PHASE_FIX(st, l)   glu_fixup_phase(st, args.in[14] + (size_t)(l) * 3 * DFF, blk, G)
#define CONVERT(l, which)  convert_weights(args.in[3] + (size_t)(l) * DM * INCOLS, args.in[10] + (size_t)(l) * DM * DM, args.in[13] + (size_t)(l) * DM * NUP, args.in[15] + (size_t)(l) * DFF * DM, which, ws, lds, blk, G)
    constexpr int UP_P = (TP / 256) * (NUP / 256), UP_P_HEAD = 192 * 14;
    constexpr int IN_S = (TSM / 256) * (NIN / 256), IN_S_HEAD = 192 * 17;
    constexpr int DN_S = (TSM / 256) * (DM / 256), DN_S_HEAD = 192 * 5;
    static_assert(DN_S - DN_S_HEAD == 64 && IN_S - IN_S_HEAD == 64 * 7, "unit split");

    CONVERT(0, 3);
    norm0_phase(SP, args.in[2], blk, G); norm0_phase(SS, args.in[2], blk, G);
    GRID_BAR();
    PHASE_IN(SP); GRID_BAR();
    PHASE_SC(SP, 0); GRID_BAR();
    PHASE_PREP(SP, 0); GRID_BAR();
    if (blk < 64) { delta_scan(SP, lds, blk, G); sub_barrier(bar, 64u); combine_fast(SP, args.in[7], lds, blk, 64); __syncthreads(); PHASE_IN_R(SS, IN_S_HEAD, IN_S, 64, blk); }
    else          { PHASE_IN_R(SS, 0, IN_S_HEAD, 192, blk - 64); }
    GRID_BAR();
    PHASE_OUT(SP); GRID_BAR();

    for (int l = 0; l < DEPTH; ++l) {
        PHASE_NB(SP, l); PHASE_SC(SS, l);
        GRID_BAR();
        PHASE_PREP(SS, l);
        GRID_BAR();
        if (blk < 64) { delta_scan(SS, lds, blk, G); PHASE_UP(SP, l, UP_P_HEAD, UP_P, 64, blk); }
        else          { PHASE_UP(SP, l, 0, UP_P_HEAD, 192, blk - 64); }
        GRID_BAR();
        PHASE_COMB(SS, l); PHASE_FIX(SP, l);
        GRID_BAR();
        PHASE_OUT(SS); PHASE_DOWN(SP, 0, (TP / 256) * (DM / 256), G, blk);
        GRID_BAR();
        PHASE_NB(SS, l); PHASE_NC(SP, l);
        if (l + 1 < DEPTH) CONVERT(l + 1, 1);
        GRID_BAR();
        if (l + 1 < DEPTH) {
            PHASE_IN(SP); PHASE_UP(SS, l, 0, (TSM / 256) * (NUP / 256), G, blk);
            GRID_BAR();
            PHASE_SC(SP, l + 1); PHASE_FIX(SS, l);
            GRID_BAR();
            PHASE_PREP(SP, l + 1);
            GRID_BAR();
            if (blk < 64) { delta_scan(SP, lds, blk, G); sub_barrier(bar, 64u * (unsigned)(l + 2)); combine_fast(SP, args.in[7] + (l + 1) * 128, lds, blk, 64); __syncthreads();
                            PHASE_DOWN(SS, DN_S_HEAD, DN_S, 64, blk); }
            else          { PHASE_DOWN(SS, 0, DN_S_HEAD, 192, blk - 64); }
            GRID_BAR();
            PHASE_NC(SS, l);
            CONVERT(l + 1, 2);
            GRID_BAR();
            PHASE_OUT(SP); PHASE_IN(SS);
            GRID_BAR();
        } else {
            PHASE_UP(SS, l, 0, (TSM / 256) * (NUP / 256), G, blk);
            GRID_BAR();
            PHASE_FIX(SS, l);
            GRID_BAR();
            PHASE_DOWN(SS, 0, DN_S, G, blk);
            GRID_BAR();
            PHASE_NC(SS, l);
        }
    }
    if (__hip_atomic_load((gu32*)(ctl + CW_BAR + XB_TMO), RLX_AGENT) != 0u) {
        const float q = __builtin_nanf(""); int tz = threadIdx.x; asm volatile("" : "+v"(tz));
        for (size_t i = (size_t)blk * (NWAVES * 64) + tz; i < (size_t)TT * DM; i += (size_t)G * NWAVES * 64) args.out[i] = q;
    }
}

extern "C" void kernel_launch(void* const* d_in, const int* in_sizes, int n_in, void* d_out, int out_size, void* d_ws, size_t ws_size, hipStream_t stream) {
    static int grid = 0;
    if (grid == 0) {
        if (n_in != 17 || out_size != TT * DM || ws_size < WS_END) { fprintf(stderr, "kernel_launch: unexpected shapes (n_in %d out %d ws %zu)\n", n_in, out_size, ws_size); grid = -1; return; }
        int dev = 0, cus = 0, per_cu = 0;
        if (hipGetDevice(&dev) != hipSuccess || hipDeviceGetAttribute(&cus, hipDeviceAttributeMultiprocessorCount, dev) != hipSuccess) { grid = -1; return; }
        if (hipFuncSetAttribute((const void*)enc_fwd, hipFuncAttributeMaxDynamicSharedMemorySize, LDS_BYTES) != hipSuccess) { fprintf(stderr, "kernel_launch: hipFuncSetAttribute failed\n"); grid = -1; return; }
        if (hipOccupancyMaxActiveBlocksPerMultiprocessor(&per_cu, (const void*)enc_fwd, NWAVES * 64, LDS_BYTES) != hipSuccess || per_cu < 1) { fprintf(stderr, "kernel_launch: occupancy query says %d\n", per_cu); grid = -1; (void)hipGetLastError(); return; }
        grid = cus;
    }
    if (grid < 0) return;
    if (hipMemsetAsync((char*)d_ws + WS_CTL, 0, CTL_ZERO_BYTES, stream) != hipSuccess) return;
    Args a{};
    for (int i = 0; i < 17; ++i) a.in[i] = (const float*)d_in[i];
    a.out = (float*)d_out; a.ws = (unsigned char*)d_ws;
    hipLaunchKernelGGL(enc_fwd, dim3(grid), dim3(NWAVES * 64), LDS_BYTES, stream, a);
}
```
